# Optimizing an MI355X kernel written in HIP

```python
import jax, jax.numpy as jnp
from jax import lax
import numpy as np

D_MODEL = 1024
BATCH = 2
SEQ = 8192
DEPTH = 1

D_MIX = D_MODEL
RET_HEADS = 4
RET_WIDTH = D_MIX // 2
RET_HEAD_DIM = RET_WIDTH // RET_HEADS
RET_CHUNK = 128
ROPE_BASE = 10000.0
SGU_GROUPS = 4
SGU_WIDTH = D_MIX - RET_WIDTH
SGU_GROUP_DIM = SGU_WIDTH // SGU_GROUPS
SGU_CHUNK = 128
IN_COLS = 4 * RET_WIDTH + 2 * SGU_WIDTH
N_EXPERT_GROUPS = 4
EXPERTS_PER_GROUP = 8
TOP_K = 2
EXPERT_FF = D_MODEL // 4
ROUTER_BIAS_SCALE = 0.01
EPS = 1e-6

kernel_name = 'hybrid_retention_sgu_hmoe_block'


def rmsnorm(x, gain):
    x32 = x.astype(jnp.float32)
    y = x32 * lax.rsqrt(jnp.mean(x32 * x32, axis=-1, keepdims=True) + EPS)
    return (y * gain.astype(jnp.float32)).astype(x.dtype)


def rotary(x, positions):
    d = x.shape[-1]
    half = d // 2
    inv_freq = ROPE_BASE ** (-jnp.arange(half, dtype=jnp.float32) * 2.0 / d)
    ang = positions.astype(jnp.float32)[:, :, None, None] * inv_freq
    cos, sin = jnp.cos(ang), jnp.sin(ang)
    x32 = x.astype(jnp.float32)
    x1, x2 = x32[..., :half], x32[..., half:]
    return jnp.concatenate([x1 * cos - x2 * sin, x1 * sin + x2 * cos], axis=-1)


def retention(q, k, v, gate, positions, gn_gain):
    out_dtype = gate.dtype
    B, S, _ = q.shape
    H, dh, C = RET_HEADS, RET_HEAD_DIM, RET_CHUNK
    N = S // C
    q = rotary(q.reshape(B, S, H, dh), positions)
    k = rotary(k.reshape(B, S, H, dh), positions) * (dh ** -0.5)
    v = v.reshape(B, S, H, dh).astype(jnp.float32)
    log_gamma = jnp.log(1.0 - 2.0 ** (-5.0 - jnp.arange(H, dtype=jnp.float32)))
    idx = jnp.arange(C, dtype=jnp.float32)
    diff = idx[:, None] - idx[None, :]
    decay_intra = jnp.where(diff >= 0.0,
                            jnp.exp(log_gamma[:, None, None] * jnp.maximum(diff, 0.0)), 0.0)
    qc = q.reshape(B, N, C, H, dh)
    kc = k.reshape(B, N, C, H, dh)
    vc = v.reshape(B, N, C, H, dh)
    scores = jnp.einsum('bnihd,bnjhd->bnhij', qc, kc) * decay_intra
    intra = jnp.einsum('bnhij,bnjhe->bnihe', scores, vc)
    k_decay = jnp.exp(log_gamma[:, None] * (C - 1.0 - idx))
    kv = jnp.einsum('bnjhd,hj,bnjhe->nbhde', kc, k_decay, vc)
    chunk_decay = jnp.exp(log_gamma * C)[None, :, None, None]

    def step(state, kv_n):
        return state * chunk_decay + kv_n, state

    _, state_prev = lax.scan(step, jnp.zeros((B, H, dh, dh), jnp.float32), kv)
    q_decay = jnp.exp(log_gamma[:, None] * (idx + 1.0))
    cross = jnp.einsum('bnihd,nbhde,hi->bnihe', qc, state_prev, q_decay)
    o = (intra + cross).reshape(B, S, H, dh)
    mu = jnp.mean(o, axis=-1, keepdims=True)
    var = jnp.mean(jnp.square(o - mu), axis=-1, keepdims=True)
    o = ((o - mu) * lax.rsqrt(var + EPS)).reshape(B, S, RET_WIDTH) * gn_gain.astype(jnp.float32)
    return (jax.nn.silu(gate.astype(jnp.float32)) * o).astype(out_dtype)


def spatial_gating(u, v, w_s, b_s, norm_gain):
    B, S, _ = u.shape
    G, dg, C = SGU_GROUPS, SGU_GROUP_DIM, SGU_CHUNK
    N = S // C
    v32 = v.astype(jnp.float32).reshape(B, N, C, G, dg)
    v32 = v32 * lax.rsqrt(jnp.mean(v32 * v32, axis=-1, keepdims=True) + EPS)
    v32 = v32 * norm_gain.astype(jnp.float32).reshape(G, dg)
    causal = jnp.tril(jnp.ones((C, C), jnp.float32))
    w = w_s.astype(jnp.float32) * causal
    s = jnp.einsum('gij,bnjgc->bnigc', w, v32) + b_s.astype(jnp.float32).T[None, None, :, :, None]
    out = u.astype(jnp.float32).reshape(B, N, C, G, dg) * s
    return out.reshape(B, S, SGU_WIDTH).astype(u.dtype)


def hierarchical_moe(h, w_rg, b_rg, w_re, b_re, w_gate_up, w_up, w_down):
    B, S, D = h.shape
    T = B * S
    G, E = N_EXPERT_GROUPS, EXPERTS_PER_GROUP
    t = h.reshape(T, D)
    t32 = t.astype(jnp.float32)
    group_logits = t32 @ w_rg.astype(jnp.float32) + b_rg.astype(jnp.float32)
    group_prob = jax.nn.softmax(group_logits, axis=-1)
    gsel = jax.nn.one_hot(jnp.argmax(group_logits, axis=-1), G, dtype=jnp.float32)
    gweight = jnp.sum(group_prob * gsel, axis=-1)
    exp_logits = jnp.einsum('td,gde->tge', t32, w_re.astype(jnp.float32)) + b_re.astype(jnp.float32)
    sel_logits = jnp.sum(exp_logits * gsel[:, :, None], axis=1)
    top_v, top_i = lax.top_k(sel_logits, TOP_K)
    top_w = jax.nn.softmax(top_v, axis=-1)
    ew = jnp.sum(jax.nn.one_hot(top_i, E, dtype=jnp.float32) * top_w[..., None], axis=1)
    gates = (gweight[:, None] * gsel)[:, :, None] * ew[:, None, :]
    y = jnp.zeros((T, D), jnp.float32)
    for g in range(G):
        a = jnp.einsum('td,edf->tef', t, w_gate_up[g])
        b = jnp.einsum('td,edf->tef', t, w_up[g])
        act = jax.nn.silu(a) * b * gates[:, g, :, None].astype(a.dtype)
        y = y + jnp.einsum('tef,efd->td', act, w_down[g]).astype(jnp.float32)
    return y.reshape(B, S, D).astype(h.dtype)


def setup_inputs(seed: int = 0) -> dict:
    key = jax.random.key(seed)
    ks = jax.random.split(key, 17)
    G, E, F = N_EXPERT_GROUPS, EXPERTS_PER_GROUP, EXPERT_FF
    nrm = jax.random.normal
    return {
        'x': nrm(ks[0], (BATCH, SEQ, D_MODEL), jnp.float32),
        'positions': jnp.broadcast_to(jnp.arange(SEQ, dtype=jnp.int32), (BATCH, SEQ)),
        'norm_mix_gain': 1.0 + 0.02 * nrm(ks[1], (DEPTH, D_MODEL), jnp.float32),
        'w_in': nrm(ks[2], (DEPTH, D_MODEL, IN_COLS), jnp.float32) * D_MODEL ** -0.5,
        'ret_gn_gain': 1.0 + 0.02 * nrm(ks[3], (DEPTH, RET_WIDTH), jnp.float32),
        'sgu_norm_gain': 1.0 + 0.02 * nrm(ks[4], (DEPTH, SGU_WIDTH), jnp.float32),
        'sgu_w': nrm(ks[5], (DEPTH, SGU_GROUPS, SGU_CHUNK, SGU_CHUNK), jnp.float32) * SGU_CHUNK ** -0.5,
        'sgu_b': 1.0 + 0.1 * nrm(ks[6], (DEPTH, SGU_GROUPS, SGU_CHUNK), jnp.float32),
        'w_out': nrm(ks[7], (DEPTH, D_MIX, D_MODEL), jnp.float32) * D_MIX ** -0.5,
        'norm_ffn_gain': 1.0 + 0.02 * nrm(ks[8], (DEPTH, D_MODEL), jnp.float32),
        'w_router_group': nrm(ks[9], (DEPTH, D_MODEL, G), jnp.float32) * D_MODEL ** -0.5,
        'b_router_group': ROUTER_BIAS_SCALE * nrm(ks[10], (DEPTH, G), jnp.float32),
        'w_router_expert': nrm(ks[11], (DEPTH, G, D_MODEL, E), jnp.float32) * D_MODEL ** -0.5,
        'b_router_expert': ROUTER_BIAS_SCALE * nrm(ks[12], (DEPTH, G, E), jnp.float32),
        'w_expert_gate_up': nrm(ks[13], (DEPTH, G, E, D_MODEL, F), jnp.float32) * D_MODEL ** -0.5,
        'w_expert_up': nrm(ks[14], (DEPTH, G, E, D_MODEL, F), jnp.float32) * D_MODEL ** -0.5,
        'w_expert_down': nrm(ks[15], (DEPTH, G, E, F, D_MODEL), jnp.float32) * F ** -0.5,
        'final_norm_gain': 1.0 + 0.02 * nrm(ks[16], (D_MODEL,), jnp.float32),
    }


def reference(x, positions, norm_mix_gain, w_in, ret_gn_gain, sgu_norm_gain, sgu_w, sgu_b, w_out,
              norm_ffn_gain, w_router_group, b_router_group, w_router_expert, b_router_expert,
              w_expert_gate_up, w_expert_up, w_expert_down, final_norm_gain):
    R, U = RET_WIDTH, SGU_WIDTH
    splits = [R, 2 * R, 3 * R, 4 * R, 4 * R + U]
    for l in range(DEPTH):
        h = rmsnorm(x, norm_mix_gain[l])
        proj = h @ w_in[l]
        q, k, v, gate, u, vs = jnp.split(proj, splits, axis=-1)
        ret = retention(q, k, v, gate, positions, ret_gn_gain[l])
        sgu = spatial_gating(jax.nn.gelu(u, approximate=False), jax.nn.gelu(vs, approximate=False),
                             sgu_w[l], sgu_b[l], sgu_norm_gain[l])
        x = x + jnp.concatenate([ret, sgu], axis=-1) @ w_out[l]
        x = x + hierarchical_moe(rmsnorm(x, norm_ffn_gain[l]), w_router_group[l], b_router_group[l],
                                 w_router_expert[l], b_router_expert[l], w_expert_gate_up[l],
                                 w_expert_up[l], w_expert_down[l])
    return rmsnorm(x, final_norm_gain)
```

```cpp
#include <hip/hip_runtime.h>
#include <cstdio>
#include <cstdint>

namespace {
constexpr int B_ = 2, S_ = 8192, T_ = B_ * S_, D_ = 1024;
constexpr int RH = 4, DH = 128, CH = 128, NCH = S_ / CH;
constexpr int NIN = 3072;
constexpr int C_Q = 0, C_K = 512, C_V = 1024, C_G = 1536, C_U = 2048, C_VS = 2560;
constexpr int NEXP = 32, FF = 256;
constexpr int MAXENT = 2 * T_ + NEXP * 256;
constexpr int MAXTILES = MAXENT / 256;
constexpr float EPS = 1e-6f;

typedef unsigned short bf16;
typedef float f32x4 __attribute__((ext_vector_type(4)));

constexpr size_t MiB = 1u << 20;
constexpr size_t WS_CTL = 0;
constexpr size_t WS_WIN_T = 1 * MiB, WS_WOUT_T = 7 * MiB, WS_WGU_T = 9 * MiB, WS_WDN_T = 41 * MiB;
constexpr size_t WS_ROUTE = 57 * MiB;
constexpr size_t WS_CNT = 57 * MiB + 256 * 1024;
constexpr size_t WS_ETOK = 57 * MiB + 512 * 1024;
constexpr size_t WS_EW = 57 * MiB + 768 * 1024;
constexpr size_t WS_TOKPOS = 58 * MiB;
constexpr size_t WS_TILE = 58 * MiB + 256 * 1024;
constexpr size_t WS_SSQ = 59 * MiB;
constexpr size_t WS_WSM = 60 * MiB;
constexpr size_t WS_WRT = 60 * MiB + 512 * 1024;
constexpr size_t WS_H = 64 * MiB;
constexpr size_t WS_ST = 64 * MiB;
constexpr size_t WS_PROJ = 96 * MiB;
constexpr size_t WS_YE = 96 * MiB;
constexpr size_t WS_TMP = 96 * MiB;
constexpr size_t WS_MIX = 192 * MiB;
constexpr size_t WS_ACT = 192 * MiB;
constexpr size_t WS_KVT = 224 * MiB;
constexpr size_t WS_ROPE = 224 * MiB;
constexpr size_t WS_END = 256 * MiB;

struct P {
    const float* x; const int* pos; const float *g_mix, *w_in, *gn_gain, *sgu_gain, *sgu_w, *sgu_b, *w_out, *g_ffn, *w_rg, *b_rg, *w_re, *b_re, *w_gu, *w_up, *w_dn, *g_fin;
    float* out; unsigned char* ws;
};

__device__ __forceinline__ float bf2f(bf16 b) { return __uint_as_float(((unsigned)b) << 16); }
__device__ __forceinline__ bf16 f2bf(float f) { unsigned u = __float_as_uint(f); u += 0x7fffu + ((u >> 16) & 1u); return (bf16)(u >> 16); }
__device__ __forceinline__ unsigned pk2(float lo, float hi) { return (unsigned)f2bf(lo) | ((unsigned)f2bf(hi) << 16); }
__device__ __forceinline__ float wave_sum(float v) {
#pragma unroll
    for (int o = 32; o >= 1; o >>= 1) v += __shfl_xor(v, o);
    return v;
}
__device__ __forceinline__ float silu_f(float v) { return v / (1.0f + __expf(-v)); }
__device__ __forceinline__ float gelu_f(float v) { return 0.5f * v * (1.0f + erff(v * 0.70710678118654752f)); }
__device__ __forceinline__ float log2_gamma(int h) { return log2f(1.0f - exp2f(-5.0f - (float)h)); }
__device__ __forceinline__ float inv_freq(int j) { return powf(10000.0f, -(float)j * (2.0f / 128.0f)); }

__device__ __forceinline__ void ph_rmsnorm_bf16(const float* X, const float* gain, bf16* H, int gw, int ngw, int lane) {
    for (int m = gw; m < T_; m += ngw) {
        const f32x4* xr = (const f32x4*)(X + (size_t)m * D_) + lane;
        f32x4 v[4]; float s = 0.f;
#pragma unroll
        for (int j = 0; j < 4; ++j) { v[j] = xr[64 * j]; s += (v[j].x * v[j].x + v[j].y * v[j].y) + (v[j].z * v[j].z + v[j].w * v[j].w); }
        const float rstd = 1.0f / sqrtf(wave_sum(s) * (1.0f / D_) + EPS);
        unsigned long long* o8 = (unsigned long long*)(H + (size_t)m * D_) + lane;
#pragma unroll
        for (int j = 0; j < 4; ++j) { const f32x4 g = ((const f32x4*)gain)[lane + 64 * j];
            o8[64 * j] = (unsigned long long)pk2(v[j].x * rstd * g.x, v[j].y * rstd * g.y) | ((unsigned long long)pk2(v[j].z * rstd * g.z, v[j].w * rstd * g.w) << 32); }
    }
}

__device__ __forceinline__ void ph_scan(const float* KVT, bf16* ST, int gtid, int ngt) {
    for (int item = gtid; item < B_ * RH * 128 * 32; item += ngt) {
        const int d4 = item & 31, e = (item >> 5) & 127, h = (item >> 12) & 3, b = item >> 14;
        const float G = exp2f(128.0f * log2_gamma(h));
        f32x4 s = (f32x4){0.f, 0.f, 0.f, 0.f};
        const size_t nstride = (size_t)RH * 16384;
        const size_t base = ((size_t)(b * NCH) * RH + h) * 16384 + (size_t)e * 128 + d4 * 4;
        for (int n0 = 0; n0 < NCH; n0 += 16) {
            f32x4 kv[16];
#pragma unroll
            for (int i = 0; i < 16; ++i) kv[i] = *(const f32x4*)(KVT + base + (size_t)(n0 + i) * nstride);
#pragma unroll
            for (int i = 0; i < 16; ++i) {
                *(unsigned long long*)(ST + base + (size_t)(n0 + i) * nstride) = (unsigned long long)pk2(s.x, s.y) | ((unsigned long long)pk2(s.z, s.w) << 32);
                s = s * G + kv[i];
            }
        }
    }
}

__device__ __forceinline__ void route_decide(const float (&lg)[4], const float (&le)[4][8], int& e1, int& e2, float& w1, float& w2) {
    int gs = 0; float gm = lg[0];
#pragma unroll
    for (int g = 1; g < 4; ++g) if (lg[g] > gm) { gm = lg[g]; gs = g; }
    float den = 0.f;
#pragma unroll
    for (int g = 0; g < 4; ++g) den += __expf(lg[g] - gm);
    const float gweight = 1.0f / den;
    float sel[8];
#pragma unroll
    for (int e = 0; e < 8; ++e) { sel[e] = le[0][e];
#pragma unroll
        for (int g = 1; g < 4; ++g) sel[e] = (gs == g) ? le[g][e] : sel[e]; }
    int i1 = 0; float v1 = sel[0];
#pragma unroll
    for (int e = 1; e < 8; ++e) if (sel[e] > v1) { v1 = sel[e]; i1 = e; }
    int i2 = -1; float v2 = -3.0e38f;
#pragma unroll
    for (int e = 0; e < 8; ++e) if (e != i1 && sel[e] > v2) { v2 = sel[e]; i2 = e; }
    const float ex = __expf(v2 - v1);
    const float a = 1.0f / (1.0f + ex);
    e1 = gs * 8 + i1; e2 = gs * 8 + i2; w1 = gweight * a; w2 = gweight * ex * a;
}

__device__ __forceinline__ void ph_rank(int4* ROUTE, int* CNT, int gw, int ngw, int lane) {
    for (int c = gw; c < T_ / 64; c += ngw) {
        int4 r = ROUTE[c * 64 + lane];
        const int e1 = r.x & 255, e2 = r.y & 255;
        int r1 = 0, r2 = 0, mycnt = 0;
        const unsigned long long lt = (1ull << lane) - 1ull;
        for (int e = 0; e < NEXP; ++e) {
            const unsigned long long m = __ballot(e1 == e || e2 == e);
            const int below = __popcll(m & lt);
            if (e1 == e) r1 = below;
            if (e2 == e) r2 = below;
            if (lane == e) mycnt = __popcll(m);
        }
        r.x = e1 | (r1 << 8); r.y = e2 | (r2 << 8);
        ROUTE[c * 64 + lane] = r;
        if (lane < NEXP) CNT[c * NEXP + lane] = mycnt;
    }
}

__device__ __forceinline__ void ph_lists(const int4* ROUTE, const int* CNT, int* ETOK, float* EW, int2* TOKPOS, int* TILE, int* lds, int bid, int nblk) {
    const int tid = threadIdx.x;
    int* psum = lds;
    int* tot = lds + 512;
    int* off = lds + 544;
    int* base = lds + 576;
    { const int e = tid & 31, part = tid >> 5; int s = 0;
      for (int i = 0; i < 16; ++i) s += CNT[(part * 16 + i) * NEXP + e];
      psum[part * 32 + e] = s; }
    __syncthreads();
    if (tid < 32) { int s = 0; for (int p = 0; p < 16; ++p) s += psum[p * 32 + tid]; tot[tid] = s; }
    __syncthreads();
    if (tid == 0) { int o = 0; for (int e = 0; e < NEXP; ++e) { off[e] = o; o += ((tot[e] + 255) >> 8) << 8; } lds[608] = o >> 8; }
    __syncthreads();
    const int ntiles = lds[608];
    if (bid == 0) {
        if (tid == 0) TILE[0] = ntiles;
        if (tid < NEXP) { const int t0 = off[tid] >> 8, nt = (tot[tid] + 255) >> 8; for (int i = 0; i < nt; ++i) TILE[1 + t0 + i] = tid; }
    }
    for (int e = bid; e < NEXP; e += nblk) {
        const int lo = off[e] + tot[e], hi = off[e] + (((tot[e] + 255) >> 8) << 8);
        for (int p = lo + tid; p < hi; p += blockDim.x) { ETOK[p] = 0; EW[p] = 0.f; }
    }
    for (int c = bid; c < T_ / 64; c += nblk) {
        __syncthreads();
        if (tid < 32) { int s = off[tid]; const int part = c >> 4;
            for (int p = 0; p < part; ++p) s += psum[p * 32 + tid];
            for (int ch = part * 16; ch < c; ++ch) s += CNT[ch * NEXP + tid];
            base[tid] = s; }
        __syncthreads();
        if (tid < 64) { const int t = c * 64 + tid; const int4 r = ROUTE[t];
            const int p1 = base[r.x & 255] + (r.x >> 8), p2 = base[r.y & 255] + (r.y >> 8);
            ETOK[p1] = t; EW[p1] = __int_as_float(r.z); ETOK[p2] = t; EW[p2] = __int_as_float(r.w);
            TOKPOS[t] = make_int2(p1, p2); }
    }
}

__device__ __forceinline__ void ph_final(float* out, const bf16* YE, const int2* TOKPOS, const float* gain, int gw, int ngw, int lane) {
    for (int m = gw; m < T_; m += ngw) {
        const int2 pp = TOKPOS[m];
        f32x4* xr = (f32x4*)(out + (size_t)m * D_) + lane;
        const unsigned long long* y1 = (const unsigned long long*)(YE + (size_t)pp.x * D_) + lane;
        const unsigned long long* y2 = (const unsigned long long*)(YE + (size_t)pp.y * D_) + lane;
        f32x4 v[4]; float s = 0.f;
#pragma unroll
        for (int j = 0; j < 4; ++j) {
            v[j] = xr[64 * j]; const unsigned long long a = y1[64 * j], b = y2[64 * j];
            v[j].x += bf2f((bf16)(a & 0xffff)) + bf2f((bf16)(b & 0xffff));
            v[j].y += bf2f((bf16)((a >> 16) & 0xffff)) + bf2f((bf16)((b >> 16) & 0xffff));
            v[j].z += bf2f((bf16)((a >> 32) & 0xffff)) + bf2f((bf16)((b >> 32) & 0xffff));
            v[j].w += bf2f((bf16)(a >> 48)) + bf2f((bf16)(b >> 48));
            s += (v[j].x * v[j].x + v[j].y * v[j].y) + (v[j].z * v[j].z + v[j].w * v[j].w);
        }
        const float rstd = 1.0f / sqrtf(wave_sum(s) * (1.0f / D_) + EPS);
#pragma unroll
        for (int j = 0; j < 4; ++j) { const f32x4 g = ((const f32x4*)gain)[lane + 64 * j]; xr[64 * j] = v[j] * rstd * g; }
    }
}

}
#define LAS __attribute__((address_space(3)))
namespace pg8 {
#define PG8_LAS __attribute__((address_space(3)))
typedef unsigned short bf16_t;
typedef short bf16x8 __attribute__((ext_vector_type(8)));
typedef float f32x4 __attribute__((ext_vector_type(4)));
typedef unsigned u32x4 __attribute__((ext_vector_type(4)));
constexpr int BM = 256, BK = 64, HALF = 128, HTB = HALF * BK * 2  , STAGE_BYTES = 8 * HTB, NXCD = 8, WGM = 8;

__host__ __device__ __forceinline__ int lds_byte(int r, int c) { const int st = (r >> 4) * 2 + (c >> 5), rr = r & 15, cc = c & 31, ob = rr * 64 + cc * 2; return st * 1024 + (ob ^ (((ob >> 9) & 1) << 5)); }
__host__ __device__ __forceinline__ void stage_rc(int b, int& R, int& C) { const int st = b / 1024, sb = b % 1024, swz = sb ^ (((sb >> 9) & 1) << 5); R = (st >> 1) * 16 + swz / 64; C = (st & 1) * 32 + (swz % 64) / 2; }
__host__ __device__ __forceinline__ int perm32(int rho) { const int n = rho >> 4, i = rho & 15; return 8 * (i >> 2) + 4 * n + (i & 3); }

struct Unit { int pm, pn; };
struct Gemm { const bf16_t* A; const bf16_t* Bt; int M, N, K; };

struct StaticOrder {
    int nM, nN, nwg, G, c;
    __host__ __device__ void init(int M, int N, int G_, int c_) { nM = M / BM; nN = N / BM; nwg = nM * nN; G = G_; c = c_; }
    __host__ __device__ bool next(int i, Unit& u) const {
        const long L = (long)i * G + c; if (L >= nwg) return false;
        int wgid = (int)L; { const int q = nwg / NXCD, r = nwg % NXCD, xcd = wgid % NXCD, off = wgid / NXCD; wgid = (xcd < r ? xcd * (q + 1) : r * (q + 1) + (xcd - r) * q) + off; }
        const int nig = WGM * nN, gid = wgid / nig, fm = gid * WGM, gsz = (nM - fm) < WGM ? (nM - fm) : WGM;
        u.pm = fm + ((wgid % nig) % gsz); u.pn = (wgid % nig) / gsz; return true;
    }
    __device__ __forceinline__ void a_ready(const Unit&) const {}
    __device__ __forceinline__ void done(const Unit&) const {}
};
__device__ __forceinline__ unsigned cvt_pk_bf16(float lo, float hi) { unsigned r; asm volatile("v_cvt_pk_bf16_f32 %0, %1, %2" : "=v"(r) : "v"(lo), "v"(hi)); return r; }
typedef float f32x2 __attribute__((ext_vector_type(2)));
__device__ __forceinline__ f32x2 gelu_pk(f32x2 v) {
    const f32x2 av = __builtin_elementwise_abs(v), d = av * 0.2316418882f + 1.0f;
    f32x2 t; t.x = __builtin_amdgcn_rcpf(d.x); t.y = __builtin_amdgcn_rcpf(d.y);
    f32x2 q = t * 0.5307027145f + (-0.7265760135f); q = q * t + 0.7107068705f; q = q * t + (-0.142248368f); q = q * t + 0.127414796f; q = q * t;
    const f32x2 s = (v * v) * (-0.72134752044f);
    f32x2 e; e.x = __builtin_amdgcn_exp2f(s.x); e.y = __builtin_amdgcn_exp2f(s.y);
    const f32x2 m = v * (q * e), r = v - m;
    f32x2 o; o.x = v.x < 0.f ? m.x : r.x; o.y = v.y < 0.f ? m.y : r.y; return o;
}
template <class Epi, class Sched, bool ALIGN_EPI = false, bool SP2 = false>
__device__ __forceinline__ void gemm_phase(PG8_LAS unsigned char* lds, const Gemm g, const Sched& S, const Epi& E) {
    const int tid = threadIdx.x, wid = __builtin_amdgcn_readfirstlane(tid >> 6), lane = tid & 63, wr = wid >> 2, wc = wid & 3, fr = lane & 15, fq = lane >> 4;
    const int K = g.K, nt = K / BK;
    unsigned voffA[2], voffB[2];
#pragma unroll
    for (int i = 0; i < 2; ++i) { int R, C; stage_rc(tid * 16 + i * 8192, R, C); const int Rb = Epi::PERM ? ((R & ~31) + perm32(R & 31)) : R;
        voffA[i] = (unsigned)(R * K + C) * 2u; voffB[i] = (unsigned)(Rb * K + C) * 2u; }
    const size_t kstep = (size_t)(BK * 2);
    const size_t hstep = (size_t)HALF * K * 2;
    const size_t tstep = 2 * hstep;
    const unsigned ldsw = (unsigned)wid * 1024u;
    const int aoff = lds_byte(wr * 64 + fr, fq * 8), boff = lds_byte(wc * 32 + fr, fq * 8);
#define PG8_SA(b, h) (((b) * 2 + (h)) * HTB)
#define PG8_SB(b, h) ((4 + (b) * 2 + (h)) * HTB)
#define PG8_STAGE(bufoff, gbase, voff) do { _Pragma("unroll") for (int _i = 0; _i < 2; ++_i) \
        __builtin_amdgcn_global_load_lds((const unsigned*)((const char*)(gbase) + (voff)[_i]), (PG8_LAS unsigned*)(lds + (bufoff) + ldsw + _i * 8192), 16, 0, 0); } while (0)
#define PG8_LDA(dst, b, h) do { _Pragma("unroll") for (int m = 0; m < 4; ++m) _Pragma("unroll") for (int k = 0; k < 2; ++k) dst[m][k] = *(const PG8_LAS bf16x8*)(lds + PG8_SA(b, h) + aoff + m * 2048 + k * 1024); } while (0)
#define PG8_LDB(dst, b, h) do { _Pragma("unroll") for (int n = 0; n < 2; ++n) _Pragma("unroll") for (int k = 0; k < 2; ++k) dst[n][k] = *(const PG8_LAS bf16x8*)(lds + PG8_SB(b, h) + boff + n * 2048 + k * 1024); } while (0)
#define PG8_MMA(ai, bj, At, Bt) do { __builtin_amdgcn_s_setprio(1); _Pragma("unroll") for (int m = 0; m < 4; ++m) _Pragma("unroll") for (int n = 0; n < 2; ++n) _Pragma("unroll") for (int k = 0; k < 2; ++k) \
        acc[ai][bj][m][n] = __builtin_amdgcn_mfma_f32_16x16x32_bf16(Bt[n][k], At[m][k], acc[ai][bj][m][n], 0, 0, 0); __builtin_amdgcn_s_setprio(0); } while (0)
#define PG8_WAIT_V(n) asm volatile("s_waitcnt vmcnt(" #n ")" ::: "memory")
#define PG8_WAIT_L(n) asm volatile("s_waitcnt lgkmcnt(" #n ")" ::: "memory")
#define PG8_BAR __builtin_amdgcn_s_barrier()
#define PG8_SCHED __builtin_amdgcn_sched_barrier(0)
    Unit cur, nxt; int ui = 0;
    if (!S.next(0, cur)) return;
    f32x4 acc[2][2][4][2];
#pragma unroll
    for (int a = 0; a < 2; ++a)
#pragma unroll
        for (int b = 0; b < 2; ++b)
#pragma unroll
            for (int m = 0; m < 4; ++m)
#pragma unroll
                for (int n = 0; n < 2; ++n) acc[a][b][m][n] = (f32x4){0.f, 0.f, 0.f, 0.f};
    bf16x8 At[4][2], B0[2][2], B1[2][2];
    const char* cA = (const char*)g.A + (size_t)cur.pm * tstep; const char* cB = (const char*)g.Bt + (size_t)cur.pn * tstep;
    S.a_ready(cur);
    if constexpr (SP2) {
        PG8_STAGE(PG8_SB(0, 0), cB, voffB); PG8_STAGE(PG8_SB(0, 1), cB + hstep, voffB); PG8_STAGE(PG8_SA(0, 0), cA, voffA); PG8_STAGE(PG8_SA(0, 1), cA + hstep, voffA);
        if (wr == 1) PG8_BAR;
        PG8_WAIT_V(2); PG8_BAR;
        PG8_STAGE(PG8_SB(1, 0), cB + kstep, voffB); PG8_STAGE(PG8_SA(1, 0), cA + kstep, voffA); PG8_STAGE(PG8_SB(1, 1), cB + hstep + kstep, voffB);
        PG8_WAIT_V(6); PG8_BAR;
    } else {
        PG8_STAGE(PG8_SB(0, 0), cB, voffB); PG8_STAGE(PG8_SA(0, 0), cA, voffA); PG8_STAGE(PG8_SB(0, 1), cB + hstep, voffB); PG8_STAGE(PG8_SA(0, 1), cA + hstep, voffA);
        if (wr == 1) PG8_BAR;
        PG8_WAIT_V(4); PG8_BAR;
        PG8_STAGE(PG8_SB(1, 0), cB + kstep, voffB); PG8_STAGE(PG8_SA(1, 0), cA + kstep, voffA); PG8_STAGE(PG8_SB(1, 1), cB + hstep + kstep, voffB);
        PG8_WAIT_V(6); PG8_BAR;
    }
    for (;;) {
        const bool has_next = S.next(ui + 1, nxt);
        const char* nA = has_next ? (const char*)g.A + (size_t)nxt.pm * tstep : cA; const char* nB = has_next ? (const char*)g.Bt + (size_t)nxt.pn * tstep : cB;
        for (int t = 0; t < nt; t += 2) {
            const bool last = (t == nt - 2);
            const char* a1 = cA + (size_t)(t + 1) * kstep;
            const char* a2 = last ? nA : cA + (size_t)(t + 2) * kstep; const char* b2 = last ? nB : cB + (size_t)(t + 2) * kstep;
            const char* a3 = a2 + kstep; const char* b3 = b2 + kstep;
            if (last && has_next) S.a_ready(nxt);
            if constexpr (SP2) {
            PG8_LDB(B0, 0, 0); PG8_LDB(B1, 0, 1); PG8_SCHED; PG8_LDA(At, 0, 0); PG8_STAGE(PG8_SA(1, 1), a1 + hstep, voffA);
            PG8_WAIT_V(8); PG8_WAIT_L(0); PG8_BAR; PG8_MMA(0, 0, At, B0); PG8_MMA(0, 1, At, B1); PG8_BAR; PG8_SCHED;
            PG8_LDA(At, 0, 1); PG8_STAGE(PG8_SB(0, 0), b2, voffB); PG8_STAGE(PG8_SB(0, 1), b2 + hstep, voffB); PG8_STAGE(PG8_SA(0, 0), a2, voffA);
            PG8_WAIT_V(8); PG8_WAIT_L(0); PG8_BAR; PG8_MMA(1, 0, At, B0); PG8_MMA(1, 1, At, B1); PG8_BAR; PG8_SCHED;
            PG8_LDB(B0, 1, 0); PG8_LDB(B1, 1, 1); PG8_SCHED; PG8_LDA(At, 1, 0); PG8_STAGE(PG8_SA(0, 1), a2 + hstep, voffA);
            PG8_WAIT_V(8); PG8_WAIT_L(0); PG8_BAR; PG8_MMA(0, 0, At, B0); PG8_MMA(0, 1, At, B1); PG8_BAR; PG8_SCHED;
            PG8_LDA(At, 1, 1); PG8_STAGE(PG8_SB(1, 0), b3, voffB); PG8_STAGE(PG8_SB(1, 1), b3 + hstep, voffB); PG8_STAGE(PG8_SA(1, 0), a3, voffA);
            PG8_WAIT_V(8); PG8_WAIT_L(0); PG8_BAR; PG8_MMA(1, 0, At, B0); PG8_MMA(1, 1, At, B1); PG8_BAR; PG8_SCHED;
            } else {
            PG8_LDB(B0, 0, 0); PG8_SCHED; PG8_LDA(At, 0, 0); PG8_STAGE(PG8_SA(1, 1), a1 + hstep, voffA);
            PG8_WAIT_L(8); PG8_BAR; PG8_WAIT_L(0); PG8_MMA(0, 0, At, B0); PG8_BAR; PG8_SCHED;
            PG8_LDB(B1, 0, 1); PG8_STAGE(PG8_SB(0, 0), b2, voffB);
            PG8_BAR; PG8_WAIT_L(0); PG8_MMA(0, 1, At, B1); PG8_BAR;
            PG8_LDA(At, 0, 1); PG8_STAGE(PG8_SA(0, 0), a2, voffA);
            PG8_BAR; PG8_WAIT_L(0); PG8_MMA(1, 0, At, B0); PG8_BAR; PG8_SCHED;
            PG8_STAGE(PG8_SB(0, 1), b2 + hstep, voffB);
            PG8_WAIT_V(6); PG8_BAR; PG8_MMA(1, 1, At, B1); PG8_BAR;
            PG8_LDB(B0, 1, 0); PG8_SCHED; PG8_LDA(At, 1, 0); PG8_STAGE(PG8_SA(0, 1), a2 + hstep, voffA);
            PG8_WAIT_L(8); PG8_BAR; PG8_WAIT_L(0); PG8_MMA(0, 0, At, B0); PG8_BAR; PG8_SCHED;
            PG8_LDB(B1, 1, 1); PG8_STAGE(PG8_SB(1, 0), b3, voffB);
            PG8_BAR; PG8_WAIT_L(0); PG8_MMA(0, 1, At, B1); PG8_BAR;
            PG8_LDA(At, 1, 1); PG8_STAGE(PG8_SA(1, 0), a3, voffA);
            PG8_BAR; PG8_WAIT_L(0); PG8_MMA(1, 0, At, B0); PG8_BAR; PG8_SCHED;
            PG8_STAGE(PG8_SB(1, 1), b3 + hstep, voffB);
            PG8_WAIT_V(6); PG8_BAR; PG8_MMA(1, 1, At, B1); PG8_BAR;
            }
        }
        if constexpr (ALIGN_EPI) { if (wr == 0) PG8_BAR; }
        if constexpr (!Epi::AFTER_DRAIN) { E(acc, cur, wr, wc, fr, fq); S.done(cur); }
        if (!has_next) break;
#pragma unroll
        for (int a = 0; a < 2; ++a)
#pragma unroll
            for (int b = 0; b < 2; ++b)
#pragma unroll
                for (int m = 0; m < 4; ++m)
#pragma unroll
                    for (int n = 0; n < 2; ++n) acc[a][b][m][n] = (f32x4){0.f, 0.f, 0.f, 0.f};
        cur = nxt; cA = nA; cB = nB; ++ui;
        if constexpr (ALIGN_EPI) { if (wr == 1) PG8_BAR; }
    }
    PG8_WAIT_V(0);
    if constexpr (!ALIGN_EPI) { if (wr == 0) PG8_BAR; }
    PG8_BAR;
    if constexpr (Epi::AFTER_DRAIN) { E.fused(acc, cur, wr, wc, fr, fq, lds, wid, lane); S.done(cur); }
#undef PG8_SA
#undef PG8_SB
#undef PG8_STAGE
#undef PG8_LDA
#undef PG8_LDB
#undef PG8_MMA
#undef PG8_WAIT_V
#undef PG8_WAIT_L
#undef PG8_BAR
#undef PG8_SCHED
}
}
namespace pg8 {
typedef unsigned u32x2 __attribute__((ext_vector_type(2)));
__device__ __forceinline__ f32x4 silu4(f32x4 v) {
    f32x4 o;
#pragma unroll
    for (int j = 0; j < 4; ++j) o[j] = v[j] * __builtin_amdgcn_rcpf(1.0f + __builtin_amdgcn_exp2f(-1.44269504089f * v[j]));
    return o;
}
struct EpiProj {
    static constexpr bool PERM = true, AFTER_DRAIN = false;
    bf16_t* O; const float* COS; const float* SIN;
    __device__ __forceinline__ void operator()(const f32x4 (&acc)[2][2][4][2], const Unit& u, int wr, int wc, int fr, int fq) const {
        const int row0 = u.pm * BM + wr * 64 + fr; const int seg = u.pn >> 1;
        if (seg <= 1) {
            const float sc = seg == 1 ? 0.08838834764831845f : 1.0f;
#pragma unroll
            for (int ai = 0; ai < 2; ++ai)
#pragma unroll
                for (int m = 0; m < 4; ++m) { const int r = row0 + ai * HALF + m * 16;
                    const f32x4 cs = *(const f32x4*)(COS + (size_t)r * 64 + 16 * wc + 4 * fq) * sc, sn = *(const f32x4*)(SIN + (size_t)r * 64 + 16 * wc + 4 * fq) * sc;
                    bf16_t* rowp = O + ((size_t)(seg * 4 + 2 * (u.pn & 1)) * 16384 + r) * 128 + 16 * wc + 4 * fq;
#pragma unroll
                    for (int bj = 0; bj < 2; ++bj) { const f32x4 x1 = acc[ai][bj][m][0], x2 = acc[ai][bj][m][1];
                        const f32x4 y1 = x1 * cs - x2 * sn, y2 = x1 * sn + x2 * cs;
                        u32x2 w1, w2; w1.x = cvt_pk_bf16(y1[0], y1[1]); w1.y = cvt_pk_bf16(y1[2], y1[3]); w2.x = cvt_pk_bf16(y2[0], y2[1]); w2.y = cvt_pk_bf16(y2[2], y2[3]);
                        *(u32x2*)(rowp + (size_t)bj * 16384 * 128) = w1; *(u32x2*)(rowp + (size_t)bj * 16384 * 128 + 64) = w2; } }
        } else {
#pragma unroll
            for (int ai = 0; ai < 2; ++ai)
#pragma unroll
                for (int m = 0; m < 4; ++m) { bf16_t* rowp = O + ((size_t)(seg * 4 + 2 * (u.pn & 1)) * 16384 + row0 + ai * HALF + m * 16) * 128 + wc * 32 + 8 * fq;
#pragma unroll
                    for (int bj = 0; bj < 2; ++bj) { f32x4 v0 = acc[ai][bj][m][0], v1 = acc[ai][bj][m][1];
                        if (seg == 3) { v0 = silu4(v0); v1 = silu4(v1); }
                        if (seg >= 4) { f32x2 a = gelu_pk((f32x2){v0[0], v0[1]}), b = gelu_pk((f32x2){v0[2], v0[3]}), c = gelu_pk((f32x2){v1[0], v1[1]}), d = gelu_pk((f32x2){v1[2], v1[3]});
                            v0 = (f32x4){a.x, a.y, b.x, b.y}; v1 = (f32x4){c.x, c.y, d.x, d.y}; }
                        u32x4 w; w.x = cvt_pk_bf16(v0[0], v0[1]); w.y = cvt_pk_bf16(v0[2], v0[3]); w.z = cvt_pk_bf16(v1[0], v1[1]); w.w = cvt_pk_bf16(v1[2], v1[3]);
                        *(u32x4*)(rowp + (size_t)bj * 16384 * 128) = w; } }
        }
    }
};
struct EpiRes {
    static constexpr bool PERM = false, AFTER_DRAIN = false;
    const float* X; float* O; float* SSQ;
    __device__ __forceinline__ void operator()(const f32x4 (&acc)[2][2][4][2], const Unit& u, int wr, int wc, int fr, int fq) const {
        const int row0 = u.pm * BM + wr * 64 + fr, col0 = u.pn * BM + wc * 32 + 4 * fq;
#pragma unroll
        for (int ai = 0; ai < 2; ++ai)
#pragma unroll
            for (int m = 0; m < 4; ++m) { const int r = row0 + ai * HALF + m * 16; const size_t off = (size_t)r * 1024 + col0; float ss = 0.f;
#pragma unroll
                for (int bj = 0; bj < 2; ++bj)
#pragma unroll
                    for (int n = 0; n < 2; ++n) { const f32x4 o = *(const f32x4*)(X + off + bj * HALF + n * 16) + acc[ai][bj][m][n];
                        *(f32x4*)(O + off + bj * HALF + n * 16) = o; ss += (o[0] * o[0] + o[1] * o[1]) + (o[2] * o[2] + o[3] * o[3]); }
                ss += __shfl_xor(ss, 16); ss += __shfl_xor(ss, 32);
                if (fq == 0) SSQ[(size_t)r * 16 + u.pn * 4 + wc] = ss;
                asm volatile("" ::: "memory"); }
    }
};
}
namespace pg8 {
struct UnitG : Unit { const char* aB; const char* bB; };
template <class Epi, class Sched>
__device__ __forceinline__ void gemm_phase_g(PG8_LAS unsigned char* lds, const int K, const Sched& S, const Epi& E) {
    const int tid = threadIdx.x, wid = __builtin_amdgcn_readfirstlane(tid >> 6), lane = tid & 63, wr = wid >> 2, wc = wid & 3, fr = lane & 15, fq = lane >> 4;
    const int nt = K / BK;
    unsigned voffB[2];
#pragma unroll
    for (int i = 0; i < 2; ++i) { int R, C; stage_rc(tid * 16 + i * 8192, R, C); const int Rb = Epi::PERM ? ((R & ~31) + perm32(R & 31)) : R;
        voffB[i] = (unsigned)(Rb * K + C) * 2u; }
    const size_t kstep = (size_t)(BK * 2);
    const size_t hstep = (size_t)HALF * K * 2;
    const unsigned ldsw = (unsigned)wid * 1024u;
    const int aoff = lds_byte(wr * 64 + fr, fq * 8), boff = lds_byte(wc * 32 + fr, fq * 8);
#define PG8_SA(b, h) (((b) * 2 + (h)) * HTB)
#define PG8_SB(b, h) ((4 + (b) * 2 + (h)) * HTB)
#define PG8_STAGE(bufoff, gbase, voff) do { _Pragma("unroll") for (int _i = 0; _i < 2; ++_i) \
        __builtin_amdgcn_global_load_lds((const unsigned*)((const char*)(gbase) + (voff)[_i]), (PG8_LAS unsigned*)(lds + (bufoff) + ldsw + _i * 8192), 16, 0, 0); } while (0)
#define PG8_LDA(dst, b, h) do { _Pragma("unroll") for (int m = 0; m < 4; ++m) _Pragma("unroll") for (int k = 0; k < 2; ++k) dst[m][k] = *(const PG8_LAS bf16x8*)(lds + PG8_SA(b, h) + aoff + m * 2048 + k * 1024); } while (0)
#define PG8_LDB(dst, b, h) do { _Pragma("unroll") for (int n = 0; n < 2; ++n) _Pragma("unroll") for (int k = 0; k < 2; ++k) dst[n][k] = *(const PG8_LAS bf16x8*)(lds + PG8_SB(b, h) + boff + n * 2048 + k * 1024); } while (0)
#define PG8_MMA(ai, bj, At, Bt) do { __builtin_amdgcn_s_setprio(1); _Pragma("unroll") for (int m = 0; m < 4; ++m) _Pragma("unroll") for (int n = 0; n < 2; ++n) _Pragma("unroll") for (int k = 0; k < 2; ++k) \
        acc[ai][bj][m][n] = __builtin_amdgcn_mfma_f32_16x16x32_bf16(Bt[n][k], At[m][k], acc[ai][bj][m][n], 0, 0, 0); __builtin_amdgcn_s_setprio(0); } while (0)
#define PG8_WAIT_V(n) asm volatile("s_waitcnt vmcnt(" #n ")" ::: "memory")
#define PG8_WAIT_L(n) asm volatile("s_waitcnt lgkmcnt(" #n ")" ::: "memory")
#define PG8_BAR __builtin_amdgcn_s_barrier()
#define PG8_SCHED __builtin_amdgcn_sched_barrier(0)
    UnitG cur, nxt; int ui = 0;
    if (!S.next(0, cur)) return;
    f32x4 acc[2][2][4][2];
#pragma unroll
    for (int a = 0; a < 2; ++a)
#pragma unroll
        for (int b = 0; b < 2; ++b)
#pragma unroll
            for (int m = 0; m < 4; ++m)
#pragma unroll
                for (int n = 0; n < 2; ++n) acc[a][b][m][n] = (f32x4){0.f, 0.f, 0.f, 0.f};
    bf16x8 At[4][2], B0[2][2], B1[2][2];
    unsigned curA[2][2], nxtA[2][2];
    S.a_offs(cur, tid, curA);
    const char* cA = cur.aB; const char* cB = cur.bB;
    PG8_STAGE(PG8_SB(0, 0), cB, voffB); PG8_STAGE(PG8_SB(0, 1), cB + hstep, voffB); PG8_STAGE(PG8_SA(0, 0), cA, curA[0]); PG8_STAGE(PG8_SA(0, 1), cA, curA[1]);
    if (wr == 1) PG8_BAR;
    PG8_WAIT_V(2); PG8_BAR;
    PG8_STAGE(PG8_SB(1, 0), cB + kstep, voffB); PG8_STAGE(PG8_SA(1, 0), cA + kstep, curA[0]); PG8_STAGE(PG8_SB(1, 1), cB + hstep + kstep, voffB);
    PG8_WAIT_V(6); PG8_BAR;
    for (;;) {
        const bool has_next = S.next(ui + 1, nxt);
        if (has_next) S.a_offs(nxt, tid, nxtA);
        else {
#pragma unroll
            for (int h = 0; h < 2; ++h)
#pragma unroll
                for (int i = 0; i < 2; ++i) nxtA[h][i] = curA[h][i]; }
        const char* nA = has_next ? nxt.aB : cA; const char* nB = has_next ? nxt.bB : cB;
#pragma unroll 1
        for (int t = 0; t < nt; t += 2) {
            const bool last = (t == nt - 2);
            const char* a1 = cA + (size_t)(t + 1) * kstep;
            const char* a2 = last ? nA : cA + (size_t)(t + 2) * kstep; const char* b2 = last ? nB : cB + (size_t)(t + 2) * kstep;
            const char* a3 = a2 + kstep; const char* b3 = b2 + kstep;
            unsigned oa2[2][2];
#pragma unroll
            for (int h = 0; h < 2; ++h)
#pragma unroll
                for (int i = 0; i < 2; ++i) oa2[h][i] = last ? nxtA[h][i] : curA[h][i];
            PG8_LDB(B0, 0, 0); PG8_LDB(B1, 0, 1); PG8_SCHED; PG8_LDA(At, 0, 0); PG8_STAGE(PG8_SA(1, 1), a1, curA[1]);
            PG8_WAIT_V(8); PG8_WAIT_L(0); PG8_BAR; PG8_MMA(0, 0, At, B0); PG8_MMA(0, 1, At, B1); PG8_BAR; PG8_SCHED;
            PG8_LDA(At, 0, 1); PG8_STAGE(PG8_SB(0, 0), b2, voffB); PG8_STAGE(PG8_SB(0, 1), b2 + hstep, voffB); PG8_STAGE(PG8_SA(0, 0), a2, oa2[0]);
            PG8_WAIT_V(8); PG8_WAIT_L(0); PG8_BAR; PG8_MMA(1, 0, At, B0); PG8_MMA(1, 1, At, B1); PG8_BAR; PG8_SCHED;
            PG8_LDB(B0, 1, 0); PG8_LDB(B1, 1, 1); PG8_SCHED; PG8_LDA(At, 1, 0); PG8_STAGE(PG8_SA(0, 1), a2, oa2[1]);
            PG8_WAIT_V(8); PG8_WAIT_L(0); PG8_BAR; PG8_MMA(0, 0, At, B0); PG8_MMA(0, 1, At, B1); PG8_BAR; PG8_SCHED;
            PG8_LDA(At, 1, 1); PG8_STAGE(PG8_SB(1, 0), b3, voffB); PG8_STAGE(PG8_SB(1, 1), b3 + hstep, voffB); PG8_STAGE(PG8_SA(1, 0), a3, oa2[0]);
            PG8_WAIT_V(8); PG8_WAIT_L(0); PG8_BAR; PG8_MMA(1, 0, At, B0); PG8_MMA(1, 1, At, B1); PG8_BAR; PG8_SCHED;
        }
        if (wr == 0) PG8_BAR;
        E(acc, cur, wr, wc, fr, fq);
        if (!has_next) break;
#pragma unroll
        for (int a = 0; a < 2; ++a)
#pragma unroll
            for (int b = 0; b < 2; ++b)
#pragma unroll
                for (int m = 0; m < 4; ++m)
#pragma unroll
                    for (int n = 0; n < 2; ++n) acc[a][b][m][n] = (f32x4){0.f, 0.f, 0.f, 0.f};
        cur = nxt; cA = nA; cB = nB; ++ui;
#pragma unroll
        for (int h = 0; h < 2; ++h)
#pragma unroll
            for (int i = 0; i < 2; ++i) curA[h][i] = nxtA[h][i];
        if (wr == 1) PG8_BAR;
    }
    PG8_WAIT_V(0);
    PG8_BAR;
#undef PG8_SA
#undef PG8_SB
#undef PG8_STAGE
#undef PG8_LDA
#undef PG8_LDB
#undef PG8_MMA
#undef PG8_WAIT_V
#undef PG8_WAIT_L
#undef PG8_BAR
#undef PG8_SCHED
}

struct MoeASched {
    const int* TILE; const int* ETOK; const char* H2; const char* WGU; int G, c;
    __device__ __forceinline__ bool next(int i, UnitG& u) const {
        const int L = i * G + c, nt = TILE[0]; if (L >= nt * 2) return false;
        const int ti = L >> 1, pn = L & 1, e = TILE[1 + ti];
        u.pm = ti; u.pn = pn; u.aB = H2; u.bB = WGU + ((size_t)e * 512 + pn * 256) * 2048; return true; }
    __device__ __forceinline__ void a_offs(const UnitG& u, int tid, unsigned (&o)[2][2]) const {
#pragma unroll
        for (int i = 0; i < 2; ++i) { int R, C; stage_rc(tid * 16 + i * 8192, R, C);
#pragma unroll
            for (int h = 0; h < 2; ++h) o[h][i] = (unsigned)ETOK[u.pm * 256 + h * 128 + R] * 2048u + (unsigned)C * 2u; } }
};
struct MoeBSched {
    const int* TILE; const char* ACT; const char* WDN; int G, c;
    __device__ __forceinline__ bool next(int i, UnitG& u) const {
        const int L = i * G + c, nt = TILE[0]; if (L >= nt * 4) return false;
        const int ti = L >> 2, pn = L & 3, e = TILE[1 + ti];
        u.pm = ti; u.pn = pn; u.aB = ACT + (size_t)ti * 256 * 512; u.bB = WDN + ((size_t)e * 1024 + pn * 256) * 512; return true; }
    __device__ __forceinline__ void a_offs(const UnitG&, int tid, unsigned (&o)[2][2]) const {
#pragma unroll
        for (int i = 0; i < 2; ++i) { int R, C; stage_rc(tid * 16 + i * 8192, R, C);
#pragma unroll
            for (int h = 0; h < 2; ++h) o[h][i] = (unsigned)((h * 128 + R) * 256 + C) * 2u; } }
};
struct EpiAct {
    static constexpr bool PERM = true, AFTER_DRAIN = false;
    bf16_t* ACT; const float* EW;
    __device__ __forceinline__ void operator()(const f32x4 (&acc)[2][2][4][2], const UnitG& u, int wr, int wc, int fr, int fq) const {
        const int row0 = u.pm * BM + wr * 64 + fr;
#pragma unroll
        for (int ai = 0; ai < 2; ++ai)
#pragma unroll
            for (int m = 0; m < 4; ++m) { const int r = row0 + ai * HALF + m * 16; const float w = EW[r];
                const f32x4 v0 = silu4(acc[ai][0][m][0]) * acc[ai][1][m][0] * w, v1 = silu4(acc[ai][0][m][1]) * acc[ai][1][m][1] * w;
                u32x4 o; o.x = cvt_pk_bf16(v0[0], v0[1]); o.y = cvt_pk_bf16(v0[2], v0[3]); o.z = cvt_pk_bf16(v1[0], v1[1]); o.w = cvt_pk_bf16(v1[2], v1[3]);
                *(u32x4*)(ACT + (size_t)r * 256 + u.pn * 128 + wc * 32 + 8 * fq) = o; }
    }
};
struct EpiYE {
    static constexpr bool PERM = true, AFTER_DRAIN = false;
    bf16_t* YE;
    __device__ __forceinline__ void operator()(const f32x4 (&acc)[2][2][4][2], const UnitG& u, int wr, int wc, int fr, int fq) const {
        const int row0 = u.pm * BM + wr * 64 + fr;
#pragma unroll
        for (int ai = 0; ai < 2; ++ai)
#pragma unroll
            for (int m = 0; m < 4; ++m) { bf16_t* rowp = YE + (size_t)(row0 + ai * HALF + m * 16) * 1024 + u.pn * BM + wc * 32 + 8 * fq;
#pragma unroll
                for (int bj = 0; bj < 2; ++bj) { const f32x4 v0 = acc[ai][bj][m][0], v1 = acc[ai][bj][m][1];
                    u32x4 o; o.x = cvt_pk_bf16(v0[0], v0[1]); o.y = cvt_pk_bf16(v0[2], v0[3]); o.z = cvt_pk_bf16(v1[0], v1[1]); o.w = cvt_pk_bf16(v1[2], v1[3]);
                    *(u32x4*)(rowp + bj * HALF) = o; } }
    }
};
}
namespace tl {
typedef short bf16x8 __attribute__((ext_vector_type(8)));
typedef short s16x4 __attribute__((ext_vector_type(4)));
typedef float f32x4 __attribute__((ext_vector_type(4)));
typedef unsigned u32x4 __attribute__((ext_vector_type(4)));
typedef unsigned u32x2 __attribute__((ext_vector_type(2)));
constexpr int TILE_BYTES = 32768;
constexpr int STAT_OFF = 131072 + 1024;
__device__ __forceinline__ unsigned off_b(unsigned row, unsigned ch) { return 256u * row + 16u * (ch ^ (((row & 3u) << 2) | ((row >> 2) & 3u))); }
__device__ __forceinline__ unsigned cvtpk(float lo, float hi) { unsigned r; asm volatile("v_cvt_pk_bf16_f32 %0, %1, %2" : "=v"(r) : "v"(lo), "v"(hi)); return r; }
__device__ __forceinline__ float blo(unsigned w) { return __uint_as_float(w << 16); }
__device__ __forceinline__ float bhi(unsigned w) { return __uint_as_float(w & 0xffff0000u); }

__device__ __forceinline__ void stage_plain(LAS unsigned char* tile, const bf16* g, size_t ld, int tid) {
#pragma unroll
    for (int i = 0; i < 4; ++i) { const int idx = tid + 512 * i, row = idx >> 4, ch = idx & 15;
        const u32x4 v = *(const u32x4*)(g + (size_t)row * ld + ch * 8);
        *(LAS u32x4*)(tile + off_b(row, ch)) = v; }
}
__device__ __forceinline__ u32x4 scale8(u32x4 v, float s) {
    u32x4 o; o.x = cvtpk(blo(v.x) * s, bhi(v.x) * s); o.y = cvtpk(blo(v.y) * s, bhi(v.y) * s); o.z = cvtpk(blo(v.z) * s, bhi(v.z) * s); o.w = cvtpk(blo(v.w) * s, bhi(v.w) * s); return o;
}
__device__ __forceinline__ void stage_decay(LAS unsigned char* tile, const bf16* g, size_t ld, int tid, float l2g) {
#pragma unroll
    for (int i = 0; i < 4; ++i) { const int idx = tid + 512 * i, row = idx >> 4, ch = idx & 15;
        const u32x4 v = *(const u32x4*)(g + (size_t)row * ld + ch * 8);
        *(LAS u32x4*)(tile + off_b(row, ch)) = scale8(v, exp2f((float)(127 - row) * l2g)); }
}
__device__ __forceinline__ void stage_rmsrow(LAS unsigned char* tile, const bf16* g, size_t ld, int tid) {
#pragma unroll
    for (int i = 0; i < 4; ++i) { const int idx = tid + 512 * i, row = idx >> 4, ch = idx & 15;
        const u32x4 v = *(const u32x4*)(g + (size_t)row * ld + ch * 8);
        float ss = (blo(v.x) * blo(v.x) + bhi(v.x) * bhi(v.x)) + (blo(v.y) * blo(v.y) + bhi(v.y) * bhi(v.y)) + (blo(v.z) * blo(v.z) + bhi(v.z) * bhi(v.z)) + (blo(v.w) * blo(v.w) + bhi(v.w) * bhi(v.w));
        ss += __shfl_xor(ss, 1); ss += __shfl_xor(ss, 2); ss += __shfl_xor(ss, 4); ss += __shfl_xor(ss, 8);
        *(LAS u32x4*)(tile + off_b(row, ch)) = scale8(v, 1.0f / sqrtf(ss * (1.0f / 128.0f) + EPS)); }
}
template <int NB> __device__ __forceinline__ void ld_row(const LAS unsigned char* tile, int rowbase, int fr, int fq, bf16x8 (&f)[NB][4]) {
#pragma unroll
    for (int i = 0; i < NB; ++i)
#pragma unroll
        for (int s = 0; s < 4; ++s) f[i][s] = *(const LAS bf16x8*)(tile + off_b(rowbase + 16 * i + fr, 4 * s + fq));
}
__device__ __forceinline__ void ld_tr(const LAS unsigned char* tile, int c, int lane, bf16x8 (&f)[4]) {
    const unsigned g = lane >> 4, q = (lane & 15) >> 2, p = lane & 3;
    const unsigned base = (unsigned)(size_t)tile;
    const unsigned a0 = base + off_b(8 * g + q, 2 * c + (p >> 1)) + 8 * (p & 1);
    const unsigned a1 = base + off_b(8 * g + 4 + q, 2 * c + (p >> 1)) + 8 * (p & 1);
    s16x4 l0, h0, l1, h1, l2, h2, l3, h3;
    asm volatile("ds_read_b64_tr_b16 %0, %8\n\tds_read_b64_tr_b16 %1, %9\n\t"
                 "ds_read_b64_tr_b16 %2, %8 offset:8192\n\tds_read_b64_tr_b16 %3, %9 offset:8192\n\t"
                 "ds_read_b64_tr_b16 %4, %8 offset:16384\n\tds_read_b64_tr_b16 %5, %9 offset:16384\n\t"
                 "ds_read_b64_tr_b16 %6, %8 offset:24576\n\tds_read_b64_tr_b16 %7, %9 offset:24576\n\t"
                 "s_waitcnt lgkmcnt(0)"
                 : "=&v"(l0), "=&v"(h0), "=&v"(l1), "=&v"(h1), "=&v"(l2), "=&v"(h2), "=&v"(l3), "=&v"(h3) : "v"(a0), "v"(a1) : "memory");
    f[0] = __builtin_shufflevector(l0, h0, 0, 1, 2, 3, 4, 5, 6, 7); f[1] = __builtin_shufflevector(l1, h1, 0, 1, 2, 3, 4, 5, 6, 7);
    f[2] = __builtin_shufflevector(l2, h2, 0, 1, 2, 3, 4, 5, 6, 7); f[3] = __builtin_shufflevector(l3, h3, 0, 1, 2, 3, 4, 5, 6, 7);
}
__device__ __forceinline__ void mma(f32x4 (&acc)[4][2], const bf16x8 (&A)[4][4], const bf16x8 (&B)[2][4]) {
#pragma unroll
    for (int s = 0; s < 4; ++s)
#pragma unroll
        for (int m = 0; m < 4; ++m)
#pragma unroll
            for (int n = 0; n < 2; ++n) acc[m][n] = __builtin_amdgcn_mfma_f32_16x16x32_bf16(B[n][s], A[m][s], acc[m][n], 0, 0, 0);
}
__device__ __forceinline__ void zero(f32x4 (&acc)[4][2]) {
#pragma unroll
    for (int m = 0; m < 4; ++m)
#pragma unroll
        for (int n = 0; n < 2; ++n) acc[m][n] = (f32x4){0.f, 0.f, 0.f, 0.f};
}

__device__ __forceinline__ void unit_kv(LAS unsigned char* lds, const bf16* PROJ, float* KVT, int u) {
    const int tid = threadIdx.x, lane = tid & 63, wid = __builtin_amdgcn_readfirstlane(tid >> 6), wr = wid >> 2, wc = wid & 3, fr = lane & 15, fq = lane >> 4;
    const int h = u & 3, n = (u >> 2) & 63, b = u >> 8; const size_t t0 = (size_t)b * S_ + (size_t)n * CH;
    LAS unsigned char* tK = lds; LAS unsigned char* tV = lds + TILE_BYTES;
    stage_decay(tK, PROJ + ((size_t)(4 + h) * T_ + t0) * 128, 128, tid, log2_gamma(h));
    stage_plain(tV, PROJ + ((size_t)(8 + h) * T_ + t0) * 128, 128, tid);
    __syncthreads();
    bf16x8 A[4][4], Bf[2][4];
#pragma unroll
    for (int m = 0; m < 4; ++m) ld_tr(tV, 4 * wr + m, lane, A[m]);
#pragma unroll
    for (int nn = 0; nn < 2; ++nn) ld_tr(tK, 2 * wc + nn, lane, Bf[nn]);
    f32x4 acc[4][2]; zero(acc); mma(acc, A, Bf);
    float* o = KVT + (size_t)u * 16384;
#pragma unroll
    for (int m = 0; m < 4; ++m)
#pragma unroll
        for (int nn = 0; nn < 2; ++nn) *(f32x4*)(o + (64 * wr + 16 * m + fr) * 128 + 32 * wc + 16 * nn + 4 * fq) = acc[m][nn];
    __syncthreads();
}
__device__ __forceinline__ void unit_sgu(LAS unsigned char* lds, const bf16* PROJ, const bf16* WSM, const float* bs, const float* gain, bf16* MIX, int u) {
    const int tid = threadIdx.x, lane = tid & 63, wid = __builtin_amdgcn_readfirstlane(tid >> 6), wr = wid >> 2, wc = wid & 3, fr = lane & 15, fq = lane >> 4;
    const int g = u & 3, n = (u >> 2) & 63, b = u >> 8; const size_t t0 = (size_t)b * S_ + (size_t)n * CH;
    LAS unsigned char* tW = lds; LAS unsigned char* tV = lds + TILE_BYTES;
    stage_plain(tW, WSM + (size_t)g * 16384, 128, tid);
    stage_rmsrow(tV, PROJ + ((size_t)(20 + g) * T_ + t0) * 128, 128, tid);
    u32x2 uu[4][2]; f32x4 gn[2]; float bi[4];
#pragma unroll
    for (int nn = 0; nn < 2; ++nn) gn[nn] = *(const f32x4*)(gain + g * 128 + 32 * wc + 16 * nn + 4 * fq);
#pragma unroll
    for (int m = 0; m < 4; ++m) { const int i = 64 * wr + 16 * m + fr; bi[m] = bs[g * 128 + i];
#pragma unroll
        for (int nn = 0; nn < 2; ++nn) uu[m][nn] = *(const u32x2*)(PROJ + ((size_t)(16 + g) * T_ + t0 + i) * 128 + 32 * wc + 16 * nn + 4 * fq); }
    __syncthreads();
    bf16x8 A[4][4], Bf[2][4];
    ld_row<4>(tW, 64 * wr, fr, fq, A);
#pragma unroll
    for (int nn = 0; nn < 2; ++nn) ld_tr(tV, 2 * wc + nn, lane, Bf[nn]);
    f32x4 acc[4][2]; zero(acc); mma(acc, A, Bf);
#pragma unroll
    for (int m = 0; m < 4; ++m) { const int i = 64 * wr + 16 * m + fr;
#pragma unroll
        for (int nn = 0; nn < 2; ++nn) { const int c = 32 * wc + 16 * nn + 4 * fq;
            const f32x4 s = acc[m][nn] * gn[nn] + bi[m];
            u32x2 o; o.x = cvtpk(blo(uu[m][nn].x) * s[0], bhi(uu[m][nn].x) * s[1]); o.y = cvtpk(blo(uu[m][nn].y) * s[2], bhi(uu[m][nn].y) * s[3]);
            *(u32x2*)(MIX + (t0 + i) * D_ + 512 + g * 128 + c) = o; } }
    __syncthreads();
}
__device__ __forceinline__ void unit_ret(LAS unsigned char* lds, const bf16* PROJ, const bf16* ST, const float* gn_gain, bf16* MIX, int u) {
    const int tid = threadIdx.x, lane = tid & 63, wid = __builtin_amdgcn_readfirstlane(tid >> 6), wr = wid >> 2, wc = wid & 3, fr = lane & 15, fq = lane >> 4;
    const int h = u & 3, n = (u >> 2) & 63, b = u >> 8; const size_t t0 = (size_t)b * S_ + (size_t)n * CH;
    LAS unsigned char* tQ = lds; LAS unsigned char* tK = lds + TILE_BYTES; LAS unsigned char* tV = lds + 2 * TILE_BYTES; LAS unsigned char* tS = lds + 3 * TILE_BYTES;
    LAS float* stat = (LAS float*)(lds + STAT_OFF);
    const float l2g = log2_gamma(h);
    stage_plain(tQ, PROJ + ((size_t)(0 + h) * T_ + t0) * 128, 128, tid);
    stage_plain(tK, PROJ + ((size_t)(4 + h) * T_ + t0) * 128, 128, tid);
    stage_plain(tV, PROJ + ((size_t)(8 + h) * T_ + t0) * 128, 128, tid);
    stage_plain(tS, ST + (size_t)u * 16384, 128, tid);
    u32x2 gt[4][2]; f32x4 gg[2];
#pragma unroll
    for (int nn = 0; nn < 2; ++nn) gg[nn] = *(const f32x4*)(gn_gain + h * 128 + 32 * wc + 16 * nn + 4 * fq);
#pragma unroll
    for (int m = 0; m < 4; ++m)
#pragma unroll
        for (int nn = 0; nn < 2; ++nn) gt[m][nn] = *(const u32x2*)(PROJ + ((size_t)(12 + h) * T_ + t0 + 64 * wr + 16 * m + fr) * 128 + 32 * wc + 16 * nn + 4 * fq);
    __syncthreads();
    bf16x8 A[4][4], Bf[2][4];
    ld_row<4>(tQ, 64 * wr, fr, fq, A);
    ld_row<2>(tS, 32 * wc, fr, fq, Bf);
    f32x4 accO[4][2]; zero(accO); mma(accO, A, Bf);
#pragma unroll
    for (int m = 0; m < 4; ++m) { const float qd = exp2f((float)(64 * wr + 16 * m + fr + 1) * l2g);
#pragma unroll
        for (int nn = 0; nn < 2; ++nn) accO[m][nn] *= qd; }
    ld_row<2>(tK, 32 * wc, fr, fq, Bf);
    f32x4 accS[4][2]; zero(accS); mma(accS, A, Bf);
    __syncthreads();
#pragma unroll
    for (int m = 0; m < 4; ++m) { const int i = 64 * wr + 16 * m + fr;
#pragma unroll
        for (int nn = 0; nn < 2; ++nn) { const int j0 = 32 * wc + 16 * nn + 4 * fq; float pv[4];
#pragma unroll
            for (int v = 0; v < 4; ++v) { const int dd = i - (j0 + v); pv[v] = dd >= 0 ? accS[m][nn][v] * exp2f((float)dd * l2g) : 0.f; }
            u32x2 o; o.x = cvtpk(pv[0], pv[1]); o.y = cvtpk(pv[2], pv[3]);
            *(LAS u32x2*)(tS + off_b(i, 4 * wc + 2 * nn + (fq >> 1)) + 8 * (fq & 1)) = o; } }
    __syncthreads();
    ld_row<4>(tS, 64 * wr, fr, fq, A);
#pragma unroll
    for (int nn = 0; nn < 2; ++nn) ld_tr(tV, 2 * wc + nn, lane, Bf[nn]);
    mma(accO, A, Bf);
#pragma unroll
    for (int m = 0; m < 4; ++m) { float s = 0.f, q = 0.f;
#pragma unroll
        for (int nn = 0; nn < 2; ++nn) { const f32x4 x = accO[m][nn]; s += (x[0] + x[1]) + (x[2] + x[3]); q += (x[0] * x[0] + x[1] * x[1]) + (x[2] * x[2] + x[3] * x[3]); }
        s += __shfl_xor(s, 16); s += __shfl_xor(s, 32); q += __shfl_xor(q, 16); q += __shfl_xor(q, 32);
        if (fq == 0) { const int i = 64 * wr + 16 * m + fr; stat[(i * 4 + wc) * 2] = s; stat[(i * 4 + wc) * 2 + 1] = q; } }
    __syncthreads();
#pragma unroll
    for (int m = 0; m < 4; ++m) { const int i = 64 * wr + 16 * m + fr;
        const f32x4 p0 = *(const LAS f32x4*)(stat + i * 8), p1 = *(const LAS f32x4*)(stat + i * 8 + 4);
        const float mu = ((p0[0] + p0[2]) + (p1[0] + p1[2])) * (1.0f / 128.0f);
        const float var = fmaxf(((p0[1] + p0[3]) + (p1[1] + p1[3])) * (1.0f / 128.0f) - mu * mu, 0.f);
        const float rstd = 1.0f / sqrtf(var + EPS);
#pragma unroll
        for (int nn = 0; nn < 2; ++nn) { const int e = 32 * wc + 16 * nn + 4 * fq;
            const f32x4 y = (accO[m][nn] - mu) * rstd * gg[nn];
            u32x2 o; o.x = cvtpk(y[0] * blo(gt[m][nn].x), y[1] * bhi(gt[m][nn].x)); o.y = cvtpk(y[2] * blo(gt[m][nn].y), y[3] * bhi(gt[m][nn].y));
            *(u32x2*)(MIX + (t0 + i) * D_ + h * 128 + e) = o; } }
    __syncthreads();
}
}
namespace rt {
typedef short bf16x8 __attribute__((ext_vector_type(8)));
typedef float f32x4 __attribute__((ext_vector_type(4)));
typedef unsigned u32x4 __attribute__((ext_vector_type(4)));
constexpr int PSTR = 49;
__device__ __forceinline__ void ph_router(LAS unsigned char* lds, const float* X1, const float* SSQ, const float* gain, const bf16* WRT, const float* brg, const float* bre,
                                          bf16* H2, int4* ROUTE, int* CNT, int bid, int nblk) {
    const int tid = threadIdx.x, lane = tid & 63, wid = __builtin_amdgcn_readfirstlane(tid >> 6), fr = lane & 15, fq = lane >> 4;
    const int rb = wid & 3, kh = wid >> 2;
    LAS float* part = (LAS float*)lds;
    for (int c = bid; c < T_ / 64; c += nblk) {
        const int row = c * 64 + 16 * rb + fr;
        float ss = 0.f;
        { const f32x4* sp = (const f32x4*)(SSQ + (size_t)row * 16);
#pragma unroll
          for (int i = 0; i < 4; ++i) { const f32x4 v = sp[i]; ss += (v[0] + v[1]) + (v[2] + v[3]); } }
        const float rstd = 1.0f / sqrtf(ss * (1.0f / D_) + EPS);
        f32x4 acc[3];
#pragma unroll
        for (int i = 0; i < 3; ++i) acc[i] = (f32x4){0.f, 0.f, 0.f, 0.f};
        const float* xr = X1 + (size_t)row * D_ + 512 * kh + 8 * fq;
        const float* gr = gain + 512 * kh + 8 * fq;
        const bf16* wr0 = WRT + (size_t)fr * D_ + 512 * kh + 8 * fq;
        bf16* hr = H2 + (size_t)row * D_ + 512 * kh + 8 * fq;
#pragma unroll 8
        for (int kc = 0; kc < 16; ++kc) {
            const f32x4 x0 = *(const f32x4*)(xr + 32 * kc), x1 = *(const f32x4*)(xr + 32 * kc + 4);
            const f32x4 g0 = *(const f32x4*)(gr + 32 * kc), g1 = *(const f32x4*)(gr + 32 * kc + 4);
            bf16x8 bh[3], bl[3];
#pragma unroll
            for (int nt = 0; nt < 3; ++nt) { bh[nt] = *(const bf16x8*)(wr0 + (size_t)(16 * nt) * D_ + 32 * kc); bl[nt] = *(const bf16x8*)(wr0 + (size_t)(48 + 16 * nt) * D_ + 32 * kc); }
            float hn[8];
#pragma unroll
            for (int j = 0; j < 4; ++j) { hn[j] = x0[j] * rstd * g0[j]; hn[4 + j] = x1[j] * rstd * g1[j]; }
            u32x4 hi, lo;
            hi.x = pk2(hn[0], hn[1]); hi.y = pk2(hn[2], hn[3]); hi.z = pk2(hn[4], hn[5]); hi.w = pk2(hn[6], hn[7]);
            lo.x = pk2(hn[0] - __uint_as_float(hi.x << 16), hn[1] - __uint_as_float(hi.x & 0xffff0000u));
            lo.y = pk2(hn[2] - __uint_as_float(hi.y << 16), hn[3] - __uint_as_float(hi.y & 0xffff0000u));
            lo.z = pk2(hn[4] - __uint_as_float(hi.z << 16), hn[5] - __uint_as_float(hi.z & 0xffff0000u));
            lo.w = pk2(hn[6] - __uint_as_float(hi.w << 16), hn[7] - __uint_as_float(hi.w & 0xffff0000u));
            *(u32x4*)(hr + 32 * kc) = hi;
            const bf16x8 ah = __builtin_bit_cast(bf16x8, hi), al = __builtin_bit_cast(bf16x8, lo);
#pragma unroll
            for (int nt = 0; nt < 3; ++nt) {
                acc[nt] = __builtin_amdgcn_mfma_f32_16x16x32_bf16(bh[nt], ah, acc[nt], 0, 0, 0);
                acc[nt] = __builtin_amdgcn_mfma_f32_16x16x32_bf16(bh[nt], al, acc[nt], 0, 0, 0);
                acc[nt] = __builtin_amdgcn_mfma_f32_16x16x32_bf16(bl[nt], ah, acc[nt], 0, 0, 0);
            }
        }
#pragma unroll
        for (int nt = 0; nt < 3; ++nt)
#pragma unroll
            for (int v = 0; v < 4; ++v) part[(kh * 64 + 16 * rb + fr) * PSTR + 16 * nt + 4 * fq + v] = acc[nt][v];
        __syncthreads();
        if (wid == 0) {
            const LAS float* p0 = part + lane * PSTR; const LAS float* p1 = part + (64 + lane) * PSTR;
            float lg[4], le[4][8];
#pragma unroll
            for (int g = 0; g < 4; ++g) { lg[g] = p0[32 + g] + p1[32 + g] + brg[g];
#pragma unroll
                for (int e = 0; e < 8; ++e) le[g][e] = p0[g * 8 + e] + p1[g * 8 + e] + bre[g * 8 + e]; }
            int e1, e2; float w1, w2; route_decide(lg, le, e1, e2, w1, w2);
            int r1 = 0, r2 = 0, mycnt = 0;
            const unsigned long long lt = (1ull << lane) - 1ull;
            for (int e = 0; e < NEXP; ++e) {
                const unsigned long long m = __ballot(e1 == e || e2 == e);
                const int below = __popcll(m & lt);
                if (e1 == e) r1 = below;
                if (e2 == e) r2 = below;
                if (lane == e) mycnt = __popcll(m);
            }
            ROUTE[c * 64 + lane] = make_int4(e1 | (r1 << 8), e2 | (r2 << 8), __float_as_int(w1), __float_as_int(w2));
            if (lane < NEXP) CNT[c * NEXP + lane] = mycnt;
        }
        __syncthreads();
    }
}
}
#define XB_TMO      128
#define XB_XCNT(j)  (256  + 64 * (j))
#define XB_XSUB(j)  (1280 + 64 * (j))
#define XB_XGEN(j)  (2304 + 64 * (j))
#define XB_TOP      3328
#define XB_TOPGEN   3392
#define XCD_BAR_WORDS 3456
#define XB_SPIN_CAP (1u << 18)

__device__ __forceinline__ unsigned xb_ld(unsigned* p)              { return __hip_atomic_load(p, __ATOMIC_RELAXED, __HIP_MEMORY_SCOPE_AGENT); }
__device__ __forceinline__ unsigned xb_add(unsigned* p, unsigned v) { return __hip_atomic_fetch_add(p, v, __ATOMIC_RELAXED, __HIP_MEMORY_SCOPE_AGENT); }
__device__ __forceinline__ unsigned xb_xcc_id() { return (unsigned)__builtin_amdgcn_s_getreg((3 << 11) | 20) & 0xFu; }
#define XB_SPIN(cond, bar) do { unsigned _sp = 0; while (cond) { __builtin_amdgcn_s_sleep(1); \
    if ((++_sp & 255u) == 0u) { if (xb_ld(&(bar)[XB_TMO])) break; if (_sp > XB_SPIN_CAP) { atomicAdd(&(bar)[XB_TMO], 1u); break; } } } } while (0)

struct XcdBarrier {
    unsigned* bar; unsigned x;
    volatile LAS unsigned* st;
};

__device__ __forceinline__ XcdBarrier xcd_barrier_post(unsigned* bar, volatile LAS unsigned* st) {
    XcdBarrier b; b.bar = bar; b.x = xb_xcc_id(); b.st = st;
    if (threadIdx.x == 0) (void)xb_add(&bar[XB_XCNT(b.x)], 1u);
    return b;
}
__device__ __forceinline__ void xcd_barrier_complete(unsigned* bar, unsigned x, unsigned& nloc, unsigned& nx) {
    const unsigned G = gridDim.x * gridDim.y * gridDim.z;
    unsigned sum, cnt, mine, sp = 0u;
    for (;;) {
        sum = 0u; cnt = 0u; mine = 0u;
#pragma unroll
        for (unsigned j = 0; j < 16; ++j) { const unsigned c = xb_ld(&bar[XB_XCNT(j)]); sum += c; cnt += (c > 0u) ? 1u : 0u; mine = (j == x) ? c : mine; }
        if (sum == G) break;
        __builtin_amdgcn_s_sleep(1);
        if ((++sp & 255u) == 0u) { if (xb_ld(&bar[XB_TMO])) break; if (sp > XB_SPIN_CAP) { atomicAdd(&bar[XB_TMO], 1u); break; } }
    }
    nloc = mine > 0u ? mine : 1u; nx = cnt > 0u ? cnt : 1u;
}

__device__ __forceinline__ void xcd_barrier(const XcdBarrier& b) {
    asm volatile("s_waitcnt vmcnt(0)" ::: "memory");
    __syncthreads();
    if (threadIdx.x == 0) {
        unsigned* bar = b.bar;
        __builtin_amdgcn_s_waitcnt(0);
        unsigned nloc = b.st[0], nx = b.st[1];
        if (nloc == 0u) { xcd_barrier_complete(bar, b.x, nloc, nx); b.st[0] = nloc; b.st[1] = nx; }
        const unsigned old = xb_add(&bar[XB_XSUB(b.x)], 1u);
        const unsigned gen = old / nloc;
        if (old + 1u == (gen + 1u) * nloc) {
            __builtin_amdgcn_fence(__ATOMIC_RELEASE, "agent");
            asm volatile("s_waitcnt vmcnt(0)" ::: "memory");
            const unsigned og = xb_add(&bar[XB_TOP], 1u);
            const unsigned tg = og / nx;
            if (og + 1u == (tg + 1u) * nx) xb_add(&bar[XB_TOPGEN], 1u);
            else XB_SPIN(xb_ld(&bar[XB_TOPGEN]) == tg, bar);
            __builtin_amdgcn_fence(__ATOMIC_ACQUIRE, "agent");
            xb_add(&bar[XB_XGEN(b.x)], 1u);
            asm volatile("s_waitcnt vmcnt(0)" ::: "memory");
        } else {
            XB_SPIN(xb_ld(&bar[XB_XGEN(b.x)]) == gen, bar);
            __builtin_amdgcn_fence(__ATOMIC_ACQUIRE, "agent");
            asm volatile("s_waitcnt vmcnt(0)" ::: "memory");
        }
    }
    __syncthreads();
}
constexpr int NWAVES = 8;
constexpr int RING_OFF = 0, RING_BYTES = 131072;
constexpr int LDSCTL_OFF = RING_BYTES, MISC_OFF = LDSCTL_OFF + 320;
constexpr int LDS_BYTES = 147456;
constexpr int CW_BAR = 4096;
constexpr size_t CTL_ZERO_BYTES = 64 * 1024;
static_assert((CW_BAR + XCD_BAR_WORDS) * 4 <= (int)CTL_ZERO_BYTES, "ctl");
#define LDS_WAIT() asm volatile("s_waitcnt lgkmcnt(0)" ::: "memory")

struct Args { P p; int ph_lo, ph_hi; };

template <class RowMap>
__device__ __forceinline__ void tr_item(const float* W, int K, int N, bf16* WT, LAS float* scr, int item, int lane, RowMap rm) {
    const int nblk = N / 32, kb = item / nblk, nb = item % nblk, k0 = 64 * kb, n0 = 32 * nb;
    float wv[32];
#pragma unroll
    for (int i = 0; i < 32; ++i) { const int kk = 2 * i + (lane >> 5); wv[i] = W[(size_t)(k0 + kk) * N + n0 + (lane & 31)]; }
#pragma unroll
    for (int i = 0; i < 32; ++i) { const int kk = 2 * i + (lane >> 5); scr[kk * 33 + (lane & 31)] = wv[i]; }
    LDS_WAIT(); asm volatile("" ::: "memory");
    const int c = lane & 7;
#pragma unroll
    for (int j = 0; j < 4; ++j) { const int n = (lane >> 3) + 8 * j; const LAS float* s = scr + (8 * c) * 33 + n;
        pg8::u32x4 o; o.x = pk2(s[0 * 33], s[1 * 33]); o.y = pk2(s[2 * 33], s[3 * 33]); o.z = pk2(s[4 * 33], s[5 * 33]); o.w = pk2(s[6 * 33], s[7 * 33]);
        *(pg8::u32x4*)(WT + (size_t)rm(n0 + n) * K + k0 + 8 * c) = o; }
    LDS_WAIT(); asm volatile("" ::: "memory");
}
struct RmId { __device__ __forceinline__ int operator()(int n) const { return n; } };
struct RmQK { __device__ __forceinline__ int operator()(int a) const { return a >= 1024 ? a : ((a & ~127) | (((a >> 4) & 3) << 5) | (((a >> 2) & 3) << 3) | (((a >> 6) & 1) << 2) | (a & 3)); } };
struct RmGU { int add; __device__ __forceinline__ int operator()(int f) const { return 256 * (f >> 7) + add + (f & 127); } };

__device__ __forceinline__ void ph_prologue(const P& p, LAS unsigned char* lds, int bid, int nblk) {
    const int tid = threadIdx.x, lane = tid & 63, wave = __builtin_amdgcn_readfirstlane(tid >> 6);
    const int gw = bid * NWAVES + wave, ngw = nblk * NWAVES, gt = bid * (NWAVES * 64) + tid, ngt = nblk * NWAVES * 64;
    unsigned char* ws = p.ws;
    LAS float* scr = (LAS float*)(lds + wave * 16384);
    bf16* WIN_T = (bf16*)(ws + WS_WIN_T); bf16* WOUT_T = (bf16*)(ws + WS_WOUT_T); bf16* WGU_T = (bf16*)(ws + WS_WGU_T); bf16* WDN_T = (bf16*)(ws + WS_WDN_T);
    constexpr int I_IN = 16 * 96, I_OUT = 16 * 32, I_E = 128, NITEMS = I_IN + I_OUT + NEXP * 3 * I_E;
    for (int it = gw; it < NITEMS; it += ngw) {
        int r = it;
        if (r < I_IN) { tr_item(p.w_in, D_, NIN, WIN_T, scr, r, lane, RmQK{}); continue; } r -= I_IN;
        if (r < I_OUT) { tr_item(p.w_out, D_, D_, WOUT_T, scr, r, lane, RmId{}); continue; } r -= I_OUT;
        const int e = r / (3 * I_E), q = r % (3 * I_E);
        if (q < I_E) tr_item(p.w_gu + (size_t)e * D_ * FF, D_, FF, WGU_T + (size_t)e * 512 * D_, scr, q, lane, RmGU{0});
        else if (q < 2 * I_E) tr_item(p.w_up + (size_t)e * D_ * FF, D_, FF, WGU_T + (size_t)e * 512 * D_, scr, q - I_E, lane, RmGU{128});
        else tr_item(p.w_dn + (size_t)e * FF * D_, FF, D_, WDN_T + (size_t)e * D_ * FF, scr, q - 2 * I_E, lane, RmId{});
    }
    ph_rmsnorm_bf16(p.x, p.g_mix, (bf16*)(ws + WS_H), gw, ngw, lane);
    { float* COS = (float*)(ws + WS_ROPE); float* SIN = COS + (size_t)T_ * 64;
      for (int i = gt; i < T_ * 64; i += ngt) { const int t = i >> 6, j = i & 63; float sn, cs; sincosf((float)p.pos[t] * inv_freq(j), &sn, &cs); COS[i] = cs; SIN[i] = sn; } }
    { bf16* WSM = (bf16*)(ws + WS_WSM);
      for (int i = gt; i < 4 * 128 * 128; i += ngt) { const int jj = i & 127, ii = (i >> 7) & 127; WSM[i] = jj <= ii ? f2bf(p.sgu_w[i]) : (bf16)0; }
      bf16* WRT = (bf16*)(ws + WS_WRT);
      for (int i = gt; i < 48 * 1024; i += ngt) { const int o = i >> 10, k = i & 1023;
          const float w = o < 32 ? p.w_re[((size_t)(o >> 3) * D_ + k) * 8 + (o & 7)] : (o < 36 ? p.w_rg[k * 4 + (o - 32)] : 0.f);
          const bf16 hi = f2bf(w); WRT[i] = hi; WRT[48 * 1024 + i] = f2bf(w - bf2f(hi)); } }
}

__global__ void __launch_bounds__(NWAVES * 64, 2) mk_fwd(Args args) {
    extern __shared__ __attribute__((aligned(16))) unsigned char lds_raw[];
    LAS unsigned char* lds = (LAS unsigned char*)lds_raw;
    volatile LAS unsigned* MISC = (volatile LAS unsigned*)(lds + MISC_OFF);
    const P& p = args.p;
    const int tid = threadIdx.x, lane = tid & 63, wave = __builtin_amdgcn_readfirstlane(tid >> 6);
    const int G = gridDim.x, bid = blockIdx.x;
    const int gw = bid * NWAVES + wave, ngw = G * NWAVES, gt = bid * (NWAVES * 64) + tid, ngt = G * NWAVES * 64;
    unsigned char* ws = p.ws;
    for (int u = tid; u < (LDS_BYTES - LDSCTL_OFF) / 4; u += NWAVES * 64) ((LAS unsigned*)(lds + LDSCTL_OFF))[u] = 0u;
    __syncthreads();
    const int lo = args.ph_lo, hi = args.ph_hi;
    XcdBarrier bar; bar.bar = (unsigned*)(ws + WS_CTL) + CW_BAR; bar.x = 0; bar.st = nullptr;
    if (hi - lo > 1) bar = xcd_barrier_post((unsigned*)(ws + WS_CTL) + CW_BAR, MISC + 8);
#ifndef DUP_PHASE
#define DUP_PHASE -1
#endif
#define IN(k) (lo <= (k) && (k) < hi)
#define PH(k) for (int rep_ = 0; rep_ < ((DUP_PHASE == (k)) ? 2 : 1); ++rep_)
#define SEAM(k) do { if (IN(k) && IN((k) + 1)) xcd_barrier(bar); } while (0)

    bf16* H = (bf16*)(ws + WS_H); bf16* PROJ = (bf16*)(ws + WS_PROJ); float* KVT = (float*)(ws + WS_KVT); bf16* ST = (bf16*)(ws + WS_ST); bf16* MIX = (bf16*)(ws + WS_MIX);
    float* SSQ = (float*)(ws + WS_SSQ); int4* ROUTE = (int4*)(ws + WS_ROUTE); int* CNT = (int*)(ws + WS_CNT); int* ETOK = (int*)(ws + WS_ETOK); float* EW = (float*)(ws + WS_EW);
    int2* TOKPOS = (int2*)(ws + WS_TOKPOS); int* TILE = (int*)(ws + WS_TILE); bf16* YE = (bf16*)(ws + WS_YE);

    if (IN(0)) PH(0) { ph_prologue(p, lds, bid, G); SEAM(0); }
    if (IN(1)) PH(1) {
        pg8::Gemm g{H, (const bf16*)(ws + WS_WIN_T), T_, NIN, D_}; pg8::StaticOrder S; S.init(T_, NIN, G, bid);
        pg8::EpiProj E{PROJ, (const float*)(ws + WS_ROPE), (const float*)(ws + WS_ROPE) + (size_t)T_ * 64};
        pg8::gemm_phase<pg8::EpiProj, pg8::StaticOrder, true, true>(lds + RING_OFF, g, S, E);
        SEAM(1);
    }
    if (IN(2)) PH(2) {
        for (int w = bid; w < 1024; w += G) { if (w < 512) tl::unit_kv(lds, PROJ, KVT, w); else tl::unit_sgu(lds, PROJ, (const bf16*)(ws + WS_WSM), p.sgu_b, p.sgu_gain, MIX, w - 512); }
        SEAM(2);
    }
    if (IN(3)) PH(3) { ph_scan(KVT, ST, gt, ngt); SEAM(3); }
    if (IN(4)) PH(4) { for (int w = bid; w < 512; w += G) tl::unit_ret(lds, PROJ, ST, p.gn_gain, MIX, w); SEAM(4); }
    if (IN(5)) PH(5) {
        pg8::Gemm g{MIX, (const bf16*)(ws + WS_WOUT_T), T_, D_, D_}; pg8::StaticOrder S; S.init(T_, D_, G, bid);
        pg8::EpiRes E{p.x, p.out, SSQ};
        pg8::gemm_phase<pg8::EpiRes, pg8::StaticOrder, true, true>(lds + RING_OFF, g, S, E);
        SEAM(5);
    }
    if (IN(6)) PH(6) { rt::ph_router(lds, p.out, SSQ, p.g_ffn, (const bf16*)(ws + WS_WRT), p.b_rg, p.b_re, H, ROUTE, CNT, bid, G); SEAM(6); }
    if (IN(7)) PH(7) { __syncthreads(); ph_lists(ROUTE, CNT, ETOK, EW, TOKPOS, TILE, (int*)lds_raw, bid, G); SEAM(7); }
    if (IN(8)) PH(8) {
        pg8::MoeASched S{TILE, ETOK, (const char*)H, (const char*)(ws + WS_WGU_T), G, bid}; pg8::EpiAct E{(bf16*)(ws + WS_ACT), EW};
        pg8::gemm_phase_g<pg8::EpiAct, pg8::MoeASched>(lds + RING_OFF, D_, S, E);
        SEAM(8);
    }
    if (IN(9)) PH(9) {
        pg8::MoeBSched S{TILE, (const char*)(ws + WS_ACT), (const char*)(ws + WS_WDN_T), G, bid}; pg8::EpiYE E{YE};
        pg8::gemm_phase_g<pg8::EpiYE, pg8::MoeBSched>(lds + RING_OFF, FF, S, E);
        SEAM(9);
    }
    if (IN(10)) { ph_final(p.out, YE, TOKPOS, p.g_fin, gw, ngw, lane); }
#undef IN
#undef PH
#undef SEAM
}

extern "C" void kernel_launch(void* const* d_in, const int* in_sizes, int n_in, void* d_out, int out_size, void* d_ws, size_t ws_size, hipStream_t stream) {
    static int grid = 0;
    if (grid == 0) {
        if (n_in != 18 || ws_size < WS_END) fprintf(stderr, "kernel_launch: unexpected n_in %d / ws_size %zu\n", n_in, ws_size);
        (void)hipFuncSetAttribute((const void*)mk_fwd, hipFuncAttributeMaxDynamicSharedMemorySize, LDS_BYTES);
        int dev = 0, cus = 0, per_cu = 0;
        (void)hipGetDevice(&dev); (void)hipDeviceGetAttribute(&cus, hipDeviceAttributeMultiprocessorCount, dev);
        (void)hipOccupancyMaxActiveBlocksPerMultiprocessor(&per_cu, (const void*)mk_fwd, NWAVES * 64, LDS_BYTES);
        if (per_cu < 1) fprintf(stderr, "kernel_launch: occupancy query says %d blocks per CU\n", per_cu);
        (void)hipGetLastError();
        grid = cus > 0 ? cus : 256;
    }
    P p{};
    p.x = (const float*)d_in[0]; p.pos = (const int*)d_in[1]; p.g_mix = (const float*)d_in[2]; p.w_in = (const float*)d_in[3]; p.gn_gain = (const float*)d_in[4];
    p.sgu_gain = (const float*)d_in[5]; p.sgu_w = (const float*)d_in[6]; p.sgu_b = (const float*)d_in[7]; p.w_out = (const float*)d_in[8]; p.g_ffn = (const float*)d_in[9];
    p.w_rg = (const float*)d_in[10]; p.b_rg = (const float*)d_in[11]; p.w_re = (const float*)d_in[12]; p.b_re = (const float*)d_in[13];
    p.w_gu = (const float*)d_in[14]; p.w_up = (const float*)d_in[15]; p.w_dn = (const float*)d_in[16]; p.g_fin = (const float*)d_in[17];
    p.out = (float*)d_out; p.ws = (unsigned char*)d_ws;
    unsigned char* ws = p.ws;
    bf16* PROJ = (bf16*)(ws + WS_PROJ); float* KVT = (float*)(ws + WS_KVT); bf16* ST = (bf16*)(ws + WS_ST); bf16* MIX = (bf16*)(ws + WS_MIX);
    float* SSQ = (float*)(ws + WS_SSQ); int4* ROUTE = (int4*)(ws + WS_ROUTE); int* CNT = (int*)(ws + WS_CNT); int* ETOK = (int*)(ws + WS_ETOK); float* EW = (float*)(ws + WS_EW);
    int* TILE = (int*)(ws + WS_TILE); float* TMP = (float*)(ws + WS_TMP); bf16* ACT = (bf16*)(ws + WS_ACT); bf16* YE = (bf16*)(ws + WS_YE);
    bf16* H2 = (bf16*)(ws + WS_H);
    (void)ST; (void)SSQ;
    (void)hipMemsetAsync(ws + WS_CTL, 0, CTL_ZERO_BYTES, stream);
#define MK(lo, hi) do { Args a{}; a.p = p; a.ph_lo = (lo); a.ph_hi = (hi); hipLaunchKernelGGL(mk_fwd, dim3(grid), dim3(NWAVES * 64), LDS_BYTES, stream, a); } while (0)
    MK(0, 11);
    (void)PROJ; (void)KVT; (void)MIX; (void)H2; (void)ROUTE; (void)CNT; (void)TMP; (void)ACT; (void)YE; (void)ETOK; (void)EW; (void)TILE;
#undef MK
}
```

```cpp
#include <hip/hip_runtime.h>
#include <cstdio>
#include <cstdint>

namespace {
constexpr int B_ = 2, S_ = 8192, T_ = B_ * S_, D_ = 1024;
constexpr int RH = 4, DH = 128, CH = 128, NCH = S_ / CH;
constexpr int NIN = 3072;
constexpr int C_Q = 0, C_K = 512, C_V = 1024, C_G = 1536, C_U = 2048, C_VS = 2560;
constexpr int NEXP = 32, FF = 256;
constexpr int MAXENT = 2 * T_ + NEXP * 256;
constexpr int MAXTILES = MAXENT / 256;
constexpr float EPS = 1e-6f;

typedef unsigned short bf16;
typedef float f32x4 __attribute__((ext_vector_type(4)));

constexpr size_t MiB = 1u << 20;
constexpr size_t WS_CTL = 0;
constexpr size_t WS_WIN_T = 1 * MiB, WS_WOUT_T = 7 * MiB, WS_WGU_T = 9 * MiB, WS_WDN_T = 41 * MiB;
constexpr size_t WS_ROUTE = 57 * MiB;
constexpr size_t WS_CNT = 57 * MiB + 256 * 1024;
constexpr size_t WS_ETOK = 57 * MiB + 512 * 1024;
constexpr size_t WS_EW = 57 * MiB + 768 * 1024;
constexpr size_t WS_TOKPOS = 58 * MiB;
constexpr size_t WS_TILE = 58 * MiB + 256 * 1024;
constexpr size_t WS_SSQ = 59 * MiB;
constexpr size_t WS_WSM = 60 * MiB;
constexpr size_t WS_WRT = 60 * MiB + 512 * 1024;
constexpr size_t WS_H = 64 * MiB;
constexpr size_t WS_ST = 64 * MiB;
constexpr size_t WS_PROJ = 96 * MiB;
constexpr size_t WS_YE = 96 * MiB;
constexpr size_t WS_TMP = 96 * MiB;
constexpr size_t WS_MIX = 192 * MiB;
constexpr size_t WS_ACT = 192 * MiB;
constexpr size_t WS_KVT = 224 * MiB;
constexpr size_t WS_ROPE = 224 * MiB;
constexpr size_t WS_END = 256 * MiB;

struct P {
    const float* x; const int* pos; const float *g_mix, *w_in, *gn_gain, *sgu_gain, *sgu_w, *sgu_b, *w_out, *g_ffn, *w_rg, *b_rg, *w_re, *b_re, *w_gu, *w_up, *w_dn, *g_fin;
    float* out; unsigned char* ws;
};

__device__ __forceinline__ float bf2f(bf16 b) { return __uint_as_float(((unsigned)b) << 16); }
__device__ __forceinline__ bf16 f2bf(float f) { unsigned u = __float_as_uint(f); u += 0x7fffu + ((u >> 16) & 1u); return (bf16)(u >> 16); }
__device__ __forceinline__ unsigned pk2(float lo, float hi) { return (unsigned)f2bf(lo) | ((unsigned)f2bf(hi) << 16); }
__device__ __forceinline__ float wave_sum(float v) {
#pragma unroll
    for (int o = 32; o >= 1; o >>= 1) v += __shfl_xor(v, o);
    return v;
}
__device__ __forceinline__ float silu_f(float v) { return v / (1.0f + __expf(-v)); }
__device__ __forceinline__ float gelu_f(float v) { return 0.5f * v * (1.0f + erff(v * 0.70710678118654752f)); }
__device__ __forceinline__ float log2_gamma(int h) { return log2f(1.0f - exp2f(-5.0f - (float)h)); }
__device__ __forceinline__ float inv_freq(int j) { return powf(10000.0f, -(float)j * (2.0f / 128.0f)); }

__device__ __forceinline__ void ph_rmsnorm_bf16(const float* X, const float* gain, bf16* H, int gw, int ngw, int lane) {
    for (int m = gw; m < T_; m += ngw) {
        const f32x4* xr = (const f32x4*)(X + (size_t)m * D_) + lane;
        f32x4 v[4]; float s = 0.f;
#pragma unroll
        for (int j = 0; j < 4; ++j) { v[j] = xr[64 * j]; s += (v[j].x * v[j].x + v[j].y * v[j].y) + (v[j].z * v[j].z + v[j].w * v[j].w); }
        const float rstd = 1.0f / sqrtf(wave_sum(s) * (1.0f / D_) + EPS);
        unsigned long long* o8 = (unsigned long long*)(H + (size_t)m * D_) + lane;
#pragma unroll
        for (int j = 0; j < 4; ++j) { const f32x4 g = ((const f32x4*)gain)[lane + 64 * j];
            o8[64 * j] = (unsigned long long)pk2(v[j].x * rstd * g.x, v[j].y * rstd * g.y) | ((unsigned long long)pk2(v[j].z * rstd * g.z, v[j].w * rstd * g.w) << 32); }
    }
}

__device__ __forceinline__ void ph_scan(const float* KVT, bf16* ST, int gtid, int ngt) {
    for (int item = gtid; item < B_ * RH * 128 * 32; item += ngt) {
        const int d4 = item & 31, e = (item >> 5) & 127, h = (item >> 12) & 3, b = item >> 14;
        const float G = exp2f(128.0f * log2_gamma(h));
        f32x4 s = (f32x4){0.f, 0.f, 0.f, 0.f};
        const size_t nstride = (size_t)RH * 16384;
        const size_t base = ((size_t)(b * NCH) * RH + h) * 16384 + (size_t)e * 128 + d4 * 4;
        for (int n0 = 0; n0 < NCH; n0 += 16) {
            f32x4 kv[16];
#pragma unroll
            for (int i = 0; i < 16; ++i) kv[i] = *(const f32x4*)(KVT + base + (size_t)(n0 + i) * nstride);
#pragma unroll
            for (int i = 0; i < 16; ++i) {
                *(unsigned long long*)(ST + base + (size_t)(n0 + i) * nstride) = (unsigned long long)pk2(s.x, s.y) | ((unsigned long long)pk2(s.z, s.w) << 32);
                s = s * G + kv[i];
            }
        }
    }
}

__device__ __forceinline__ void route_decide(const float (&lg)[4], const float (&le)[4][8], int& e1, int& e2, float& w1, float& w2) {
    int gs = 0; float gm = lg[0];
#pragma unroll
    for (int g = 1; g < 4; ++g) if (lg[g] > gm) { gm = lg[g]; gs = g; }
    float den = 0.f;
#pragma unroll
    for (int g = 0; g < 4; ++g) den += __expf(lg[g] - gm);
    const float gweight = 1.0f / den;
    float sel[8];
#pragma unroll
    for (int e = 0; e < 8; ++e) { sel[e] = le[0][e];
#pragma unroll
        for (int g = 1; g < 4; ++g) sel[e] = (gs == g) ? le[g][e] : sel[e]; }
    int i1 = 0; float v1 = sel[0];
#pragma unroll
    for (int e = 1; e < 8; ++e) if (sel[e] > v1) { v1 = sel[e]; i1 = e; }
    int i2 = -1; float v2 = -3.0e38f;
#pragma unroll
    for (int e = 0; e < 8; ++e) if (e != i1 && sel[e] > v2) { v2 = sel[e]; i2 = e; }
    const float ex = __expf(v2 - v1);
    const float a = 1.0f / (1.0f + ex);
    e1 = gs * 8 + i1; e2 = gs * 8 + i2; w1 = gweight * a; w2 = gweight * ex * a;
}

__device__ __forceinline__ void ph_rank(int4* ROUTE, int* CNT, int gw, int ngw, int lane) {
    for (int c = gw; c < T_ / 64; c += ngw) {
        int4 r = ROUTE[c * 64 + lane];
        const int e1 = r.x & 255, e2 = r.y & 255;
        int r1 = 0, r2 = 0, mycnt = 0;
        const unsigned long long lt = (1ull << lane) - 1ull;
        for (int e = 0; e < NEXP; ++e) {
            const unsigned long long m = __ballot(e1 == e || e2 == e);
            const int below = __popcll(m & lt);
            if (e1 == e) r1 = below;
            if (e2 == e) r2 = below;
            if (lane == e) mycnt = __popcll(m);
        }
        r.x = e1 | (r1 << 8); r.y = e2 | (r2 << 8);
        ROUTE[c * 64 + lane] = r;
        if (lane < NEXP) CNT[c * NEXP + lane] = mycnt;
    }
}

__device__ __forceinline__ void ph_lists(const int4* ROUTE, const int* CNT, int* ETOK, float* EW, int2* TOKPOS, int* TILE, int* lds, int bid, int nblk) {
    const int tid = threadIdx.x;
    int* psum = lds;
    int* tot = lds + 512;
    int* off = lds + 544;
    int* base = lds + 576;
    { const int e = tid & 31, part = tid >> 5; int s = 0;
      for (int i = 0; i < 16; ++i) s += CNT[(part * 16 + i) * NEXP + e];
      psum[part * 32 + e] = s; }
    __syncthreads();
    if (tid < 32) { int s = 0; for (int p = 0; p < 16; ++p) s += psum[p * 32 + tid]; tot[tid] = s; }
    __syncthreads();
    if (tid == 0) { int o = 0; for (int e = 0; e < NEXP; ++e) { off[e] = o; o += ((tot[e] + 255) >> 8) << 8; } lds[608] = o >> 8; }
    __syncthreads();
    const int ntiles = lds[608];
    if (bid == 0) {
        if (tid == 0) TILE[0] = ntiles;
        if (tid < NEXP) { const int t0 = off[tid] >> 8, nt = (tot[tid] + 255) >> 8; for (int i = 0; i < nt; ++i) TILE[1 + t0 + i] = tid; }
    }
    for (int e = bid; e < NEXP; e += nblk) {
        const int lo = off[e] + tot[e], hi = off[e] + (((tot[e] + 255) >> 8) << 8);
        for (int p = lo + tid; p < hi; p += blockDim.x) { ETOK[p] = 0; EW[p] = 0.f; }
    }
    for (int c = bid; c < T_ / 64; c += nblk) {
        __syncthreads();
        if (tid < 32) { int s = off[tid]; const int part = c >> 4;
            for (int p = 0; p < part; ++p) s += psum[p * 32 + tid];
            for (int ch = part * 16; ch < c; ++ch) s += CNT[ch * NEXP + tid];
            base[tid] = s; }
        __syncthreads();
        if (tid < 64) { const int t = c * 64 + tid; const int4 r = ROUTE[t];
            const int p1 = base[r.x & 255] + (r.x >> 8), p2 = base[r.y & 255] + (r.y >> 8);
            ETOK[p1] = t; EW[p1] = __int_as_float(r.z); ETOK[p2] = t; EW[p2] = __int_as_float(r.w);
            TOKPOS[t] = make_int2(p1, p2); }
    }
}

__device__ __forceinline__ void ph_final(float* out, const bf16* YE, const int2* TOKPOS, const float* gain, int gw, int ngw, int lane) {
    for (int m = gw; m < T_; m += ngw) {
        const int2 pp = TOKPOS[m];
        f32x4* xr = (f32x4*)(out + (size_t)m * D_) + lane;
        const unsigned long long* y1 = (const unsigned long long*)(YE + (size_t)pp.x * D_) + lane;
        const unsigned long long* y2 = (const unsigned long long*)(YE + (size_t)pp.y * D_) + lane;
        f32x4 v[4]; float s = 0.f;
#pragma unroll
        for (int j = 0; j < 4; ++j) {
            v[j] = xr[64 * j]; const unsigned long long a = y1[64 * j], b = y2[64 * j];
            v[j].x += bf2f((bf16)(a & 0xffff)) + bf2f((bf16)(b & 0xffff));
            v[j].y += bf2f((bf16)((a >> 16) & 0xffff)) + bf2f((bf16)((b >> 16) & 0xffff));
            v[j].z += bf2f((bf16)((a >> 32) & 0xffff)) + bf2f((bf16)((b >> 32) & 0xffff));
            v[j].w += bf2f((bf16)(a >> 48)) + bf2f((bf16)(b >> 48));
            s += (v[j].x * v[j].x + v[j].y * v[j].y) + (v[j].z * v[j].z + v[j].w * v[j].w);
        }
        const float rstd = 1.0f / sqrtf(wave_sum(s) * (1.0f / D_) + EPS);
#pragma unroll
        for (int j = 0; j < 4; ++j) { const f32x4 g = ((const f32x4*)gain)[lane + 64 * j]; xr[64 * j] = v[j] * rstd * g; }
    }
}

}
#define LAS __attribute__((address_space(3)))
namespace pg8 {
#define PG8_LAS __attribute__((address_space(3)))
typedef unsigned short bf16_t;
typedef short bf16x8 __attribute__((ext_vector_type(8)));
typedef float f32x4 __attribute__((ext_vector_type(4)));
typedef unsigned u32x4 __attribute__((ext_vector_type(4)));
constexpr int BM = 256, BK = 64, HALF = 128, HTB = HALF * BK * 2  , STAGE_BYTES = 8 * HTB, NXCD = 8, WGM = 8;

__host__ __device__ __forceinline__ int lds_byte(int r, int c) { const int st = (r >> 4) * 2 + (c >> 5), rr = r & 15, cc = c & 31, ob = rr * 64 + cc * 2; return st * 1024 + (ob ^ (((ob >> 9) & 1) << 5)); }
__host__ __device__ __forceinline__ void stage_rc(int b, int& R, int& C) { const int st = b / 1024, sb = b % 1024, swz = sb ^ (((sb >> 9) & 1) << 5); R = (st >> 1) * 16 + swz / 64; C = (st & 1) * 32 + (swz % 64) / 2; }
__host__ __device__ __forceinline__ int perm32(int rho) { const int n = rho >> 4, i = rho & 15; return 8 * (i >> 2) + 4 * n + (i & 3); }

struct Unit { int pm, pn; };
struct Gemm { const bf16_t* A; const bf16_t* Bt; int M, N, K; };

struct StaticOrder {
    int nM, nN, nwg, G, c;
    __host__ __device__ void init(int M, int N, int G_, int c_) { nM = M / BM; nN = N / BM; nwg = nM * nN; G = G_; c = c_; }
    __host__ __device__ bool next(int i, Unit& u) const {
        const long L = (long)i * G + c; if (L >= nwg) return false;
        int wgid = (int)L; { const int q = nwg / NXCD, r = nwg % NXCD, xcd = wgid % NXCD, off = wgid / NXCD; wgid = (xcd < r ? xcd * (q + 1) : r * (q + 1) + (xcd - r) * q) + off; }
        const int nig = WGM * nN, gid = wgid / nig, fm = gid * WGM, gsz = (nM - fm) < WGM ? (nM - fm) : WGM;
        u.pm = fm + ((wgid % nig) % gsz); u.pn = (wgid % nig) / gsz; return true;
    }
    __device__ __forceinline__ void a_ready(const Unit&) const {}
    __device__ __forceinline__ void done(const Unit&) const {}
};
__device__ __forceinline__ unsigned cvt_pk_bf16(float lo, float hi) { unsigned r; asm volatile("v_cvt_pk_bf16_f32 %0, %1, %2" : "=v"(r) : "v"(lo), "v"(hi)); return r; }
typedef float f32x2 __attribute__((ext_vector_type(2)));
__device__ __forceinline__ f32x2 gelu_pk(f32x2 v) {
    const f32x2 av = __builtin_elementwise_abs(v), d = av * 0.2316418882f + 1.0f;
    f32x2 t; t.x = __builtin_amdgcn_rcpf(d.x); t.y = __builtin_amdgcn_rcpf(d.y);
    f32x2 q = t * 0.5307027145f + (-0.7265760135f); q = q * t + 0.7107068705f; q = q * t + (-0.142248368f); q = q * t + 0.127414796f; q = q * t;
    const f32x2 s = (v * v) * (-0.72134752044f);
    f32x2 e; e.x = __builtin_amdgcn_exp2f(s.x); e.y = __builtin_amdgcn_exp2f(s.y);
    const f32x2 m = v * (q * e), r = v - m;
    f32x2 o; o.x = v.x < 0.f ? m.x : r.x; o.y = v.y < 0.f ? m.y : r.y; return o;
}
template <class Epi, class Sched, bool ALIGN_EPI = false, bool SP2 = false>
__device__ __forceinline__ void gemm_phase(PG8_LAS unsigned char* lds, const Gemm g, const Sched& S, const Epi& E) {
    const int tid = threadIdx.x, wid = __builtin_amdgcn_readfirstlane(tid >> 6), lane = tid & 63, wr = wid >> 2, wc = wid & 3, fr = lane & 15, fq = lane >> 4;
    const int K = g.K, nt = K / BK;
    unsigned voffA[2], voffB[2];
#pragma unroll
    for (int i = 0; i < 2; ++i) { int R, C; stage_rc(tid * 16 + i * 8192, R, C); const int Rb = Epi::PERM ? ((R & ~31) + perm32(R & 31)) : R;
        voffA[i] = (unsigned)(R * K + C) * 2u; voffB[i] = (unsigned)(Rb * K + C) * 2u; }
    const size_t kstep = (size_t)(BK * 2);
    const size_t hstep = (size_t)HALF * K * 2;
    const size_t tstep = 2 * hstep;
    const unsigned ldsw = (unsigned)wid * 1024u;
    const int aoff = lds_byte(wr * 64 + fr, fq * 8), boff = lds_byte(wc * 32 + fr, fq * 8);
#define PG8_SA(b, h) (((b) * 2 + (h)) * HTB)
#define PG8_SB(b, h) ((4 + (b) * 2 + (h)) * HTB)
#define PG8_STAGE(bufoff, gbase, voff) do { _Pragma("unroll") for (int _i = 0; _i < 2; ++_i) \
        __builtin_amdgcn_global_load_lds((const unsigned*)((const char*)(gbase) + (voff)[_i]), (PG8_LAS unsigned*)(lds + (bufoff) + ldsw + _i * 8192), 16, 0, 0); } while (0)
#define PG8_LDA(dst, b, h) do { _Pragma("unroll") for (int m = 0; m < 4; ++m) _Pragma("unroll") for (int k = 0; k < 2; ++k) dst[m][k] = *(const PG8_LAS bf16x8*)(lds + PG8_SA(b, h) + aoff + m * 2048 + k * 1024); } while (0)
#define PG8_LDB(dst, b, h) do { _Pragma("unroll") for (int n = 0; n < 2; ++n) _Pragma("unroll") for (int k = 0; k < 2; ++k) dst[n][k] = *(const PG8_LAS bf16x8*)(lds + PG8_SB(b, h) + boff + n * 2048 + k * 1024); } while (0)
#define PG8_MMA(ai, bj, At, Bt) do { __builtin_amdgcn_s_setprio(1); _Pragma("unroll") for (int m = 0; m < 4; ++m) _Pragma("unroll") for (int n = 0; n < 2; ++n) _Pragma("unroll") for (int k = 0; k < 2; ++k) \
        acc[ai][bj][m][n] = __builtin_amdgcn_mfma_f32_16x16x32_bf16(Bt[n][k], At[m][k], acc[ai][bj][m][n], 0, 0, 0); __builtin_amdgcn_s_setprio(0); } while (0)
#define PG8_WAIT_V(n) asm volatile("s_waitcnt vmcnt(" #n ")" ::: "memory")
#define PG8_WAIT_L(n) asm volatile("s_waitcnt lgkmcnt(" #n ")" ::: "memory")
#define PG8_BAR __builtin_amdgcn_s_barrier()
#define PG8_SCHED __builtin_amdgcn_sched_barrier(0)
    Unit cur, nxt; int ui = 0;
    if (!S.next(0, cur)) return;
    f32x4 acc[2][2][4][2];
#pragma unroll
    for (int a = 0; a < 2; ++a)
#pragma unroll
        for (int b = 0; b < 2; ++b)
#pragma unroll
            for (int m = 0; m < 4; ++m)
#pragma unroll
                for (int n = 0; n < 2; ++n) acc[a][b][m][n] = (f32x4){0.f, 0.f, 0.f, 0.f};
    bf16x8 At[4][2], B0[2][2], B1[2][2];
    const char* cA = (const char*)g.A + (size_t)cur.pm * tstep; const char* cB = (const char*)g.Bt + (size_t)cur.pn * tstep;
    S.a_ready(cur);
    if constexpr (SP2) {
        PG8_STAGE(PG8_SB(0, 0), cB, voffB); PG8_STAGE(PG8_SB(0, 1), cB + hstep, voffB); PG8_STAGE(PG8_SA(0, 0), cA, voffA); PG8_STAGE(PG8_SA(0, 1), cA + hstep, voffA);
        if (wr == 1) PG8_BAR;
        PG8_WAIT_V(2); PG8_BAR;
        PG8_STAGE(PG8_SB(1, 0), cB + kstep, voffB); PG8_STAGE(PG8_SA(1, 0), cA + kstep, voffA); PG8_STAGE(PG8_SB(1, 1), cB + hstep + kstep, voffB);
        PG8_WAIT_V(6); PG8_BAR;
    } else {
        PG8_STAGE(PG8_SB(0, 0), cB, voffB); PG8_STAGE(PG8_SA(0, 0), cA, voffA); PG8_STAGE(PG8_SB(0, 1), cB + hstep, voffB); PG8_STAGE(PG8_SA(0, 1), cA + hstep, voffA);
        if (wr == 1) PG8_BAR;
        PG8_WAIT_V(4); PG8_BAR;
        PG8_STAGE(PG8_SB(1, 0), cB + kstep, voffB); PG8_STAGE(PG8_SA(1, 0), cA + kstep, voffA); PG8_STAGE(PG8_SB(1, 1), cB + hstep + kstep, voffB);
        PG8_WAIT_V(6); PG8_BAR;
    }
    for (;;) {
        const bool has_next = S.next(ui + 1, nxt);
        const char* nA = has_next ? (const char*)g.A + (size_t)nxt.pm * tstep : cA; const char* nB = has_next ? (const char*)g.Bt + (size_t)nxt.pn * tstep : cB;
        for (int t = 0; t < nt; t += 2) {
            const bool last = (t == nt - 2);
            const char* a1 = cA + (size_t)(t + 1) * kstep;
            const char* a2 = last ? nA : cA + (size_t)(t + 2) * kstep; const char* b2 = last ? nB : cB + (size_t)(t + 2) * kstep;
            const char* a3 = a2 + kstep; const char* b3 = b2 + kstep;
            if (last && has_next) S.a_ready(nxt);
            if constexpr (SP2) {
            PG8_LDB(B0, 0, 0); PG8_LDB(B1, 0, 1); PG8_SCHED; PG8_LDA(At, 0, 0); PG8_STAGE(PG8_SA(1, 1), a1 + hstep, voffA);
            PG8_WAIT_V(8); PG8_WAIT_L(0); PG8_BAR; PG8_MMA(0, 0, At, B0); PG8_MMA(0, 1, At, B1); PG8_BAR; PG8_SCHED;
            PG8_LDA(At, 0, 1); PG8_STAGE(PG8_SB(0, 0), b2, voffB); PG8_STAGE(PG8_SB(0, 1), b2 + hstep, voffB); PG8_STAGE(PG8_SA(0, 0), a2, voffA);
            PG8_WAIT_V(8); PG8_WAIT_L(0); PG8_BAR; PG8_MMA(1, 0, At, B0); PG8_MMA(1, 1, At, B1); PG8_BAR; PG8_SCHED;
            PG8_LDB(B0, 1, 0); PG8_LDB(B1, 1, 1); PG8_SCHED; PG8_LDA(At, 1, 0); PG8_STAGE(PG8_SA(0, 1), a2 + hstep, voffA);
            PG8_WAIT_V(8); PG8_WAIT_L(0); PG8_BAR; PG8_MMA(0, 0, At, B0); PG8_MMA(0, 1, At, B1); PG8_BAR; PG8_SCHED;
            PG8_LDA(At, 1, 1); PG8_STAGE(PG8_SB(1, 0), b3, voffB); PG8_STAGE(PG8_SB(1, 1), b3 + hstep, voffB); PG8_STAGE(PG8_SA(1, 0), a3, voffA);
            PG8_WAIT_V(8); PG8_WAIT_L(0); PG8_BAR; PG8_MMA(1, 0, At, B0); PG8_MMA(1, 1, At, B1); PG8_BAR; PG8_SCHED;
            } else {
            PG8_LDB(B0, 0, 0); PG8_SCHED; PG8_LDA(At, 0, 0); PG8_STAGE(PG8_SA(1, 1), a1 + hstep, voffA);
            PG8_WAIT_L(8); PG8_BAR; PG8_WAIT_L(0); PG8_MMA(0, 0, At, B0); PG8_BAR; PG8_SCHED;
            PG8_LDB(B1, 0, 1); PG8_STAGE(PG8_SB(0, 0), b2, voffB);
            PG8_BAR; PG8_WAIT_L(0); PG8_MMA(0, 1, At, B1); PG8_BAR;
            PG8_LDA(At, 0, 1); PG8_STAGE(PG8_SA(0, 0), a2, voffA);
            PG8_BAR; PG8_WAIT_L(0); PG8_MMA(1, 0, At, B0); PG8_BAR; PG8_SCHED;
            PG8_STAGE(PG8_SB(0, 1), b2 + hstep, voffB);
            PG8_WAIT_V(6); PG8_BAR; PG8_MMA(1, 1, At, B1); PG8_BAR;
            PG8_LDB(B0, 1, 0); PG8_SCHED; PG8_LDA(At, 1, 0); PG8_STAGE(PG8_SA(0, 1), a2 + hstep, voffA);
            PG8_WAIT_L(8); PG8_BAR; PG8_WAIT_L(0); PG8_MMA(0, 0, At, B0); PG8_BAR; PG8_SCHED;
            PG8_LDB(B1, 1, 1); PG8_STAGE(PG8_SB(1, 0), b3, voffB);
            PG8_BAR; PG8_WAIT_L(0); PG8_MMA(0, 1, At, B1); PG8_BAR;
            PG8_LDA(At, 1, 1); PG8_STAGE(PG8_SA(1, 0), a3, voffA);
            PG8_BAR; PG8_WAIT_L(0); PG8_MMA(1, 0, At, B0); PG8_BAR; PG8_SCHED;
            PG8_STAGE(PG8_SB(1, 1), b3 + hstep, voffB);
            PG8_WAIT_V(6); PG8_BAR; PG8_MMA(1, 1, At, B1); PG8_BAR;
            }
        }
        if constexpr (ALIGN_EPI) { if (wr == 0) PG8_BAR; }
        if constexpr (!Epi::AFTER_DRAIN) { E(acc, cur, wr, wc, fr, fq); S.done(cur); }
        if (!has_next) break;
#pragma unroll
        for (int a = 0; a < 2; ++a)
#pragma unroll
            for (int b = 0; b < 2; ++b)
#pragma unroll
                for (int m = 0; m < 4; ++m)
#pragma unroll
                    for (int n = 0; n < 2; ++n) acc[a][b][m][n] = (f32x4){0.f, 0.f, 0.f, 0.f};
        cur = nxt; cA = nA; cB = nB; ++ui;
        if constexpr (ALIGN_EPI) { if (wr == 1) PG8_BAR; }
    }
    PG8_WAIT_V(0);
    if constexpr (!ALIGN_EPI) { if (wr == 0) PG8_BAR; }
    PG8_BAR;
    if constexpr (Epi::AFTER_DRAIN) { E.fused(acc, cur, wr, wc, fr, fq, lds, wid, lane); S.done(cur); }
#undef PG8_SA
#undef PG8_SB
#undef PG8_STAGE
#undef PG8_LDA
#undef PG8_LDB
#undef PG8_MMA
#undef PG8_WAIT_V
#undef PG8_WAIT_L
#undef PG8_BAR
#undef PG8_SCHED
}
}
namespace pg8 {
typedef unsigned u32x2 __attribute__((ext_vector_type(2)));
__device__ __forceinline__ f32x4 silu4(f32x4 v) {
    f32x4 o;
#pragma unroll
    for (int j = 0; j < 4; ++j) o[j] = v[j] * __builtin_amdgcn_rcpf(1.0f + __builtin_amdgcn_exp2f(-1.44269504089f * v[j]));
    return o;
}
struct EpiProj {
    static constexpr bool PERM = true, AFTER_DRAIN = false;
    bf16_t* O; const float* COS; const float* SIN;
    __device__ __forceinline__ void operator()(const f32x4 (&acc)[2][2][4][2], const Unit& u, int wr, int wc, int fr, int fq) const {
        const int row0 = u.pm * BM + wr * 64 + fr; const int seg = u.pn >> 1;
        if (seg <= 1) {
            const float sc = seg == 1 ? 0.08838834764831845f : 1.0f;
#pragma unroll
            for (int ai = 0; ai < 2; ++ai)
#pragma unroll
                for (int m = 0; m < 4; ++m) { const int r = row0 + ai * HALF + m * 16;
                    const f32x4 cs = *(const f32x4*)(COS + (size_t)r * 64 + 16 * wc + 4 * fq) * sc, sn = *(const f32x4*)(SIN + (size_t)r * 64 + 16 * wc + 4 * fq) * sc;
                    bf16_t* rowp = O + ((size_t)(seg * 4 + 2 * (u.pn & 1)) * 16384 + r) * 128 + 16 * wc + 4 * fq;
#pragma unroll
                    for (int bj = 0; bj < 2; ++bj) { const f32x4 x1 = acc[ai][bj][m][0], x2 = acc[ai][bj][m][1];
                        const f32x4 y1 = x1 * cs - x2 * sn, y2 = x1 * sn + x2 * cs;
                        u32x2 w1, w2; w1.x = cvt_pk_bf16(y1[0], y1[1]); w1.y = cvt_pk_bf16(y1[2], y1[3]); w2.x = cvt_pk_bf16(y2[0], y2[1]); w2.y = cvt_pk_bf16(y2[2], y2[3]);
                        *(u32x2*)(rowp + (size_t)bj * 16384 * 128) = w1; *(u32x2*)(rowp + (size_t)bj * 16384 * 128 + 64) = w2; } }
        } else {
#pragma unroll
            for (int ai = 0; ai < 2; ++ai)
#pragma unroll
                for (int m = 0; m < 4; ++m) { bf16_t* rowp = O + ((size_t)(seg * 4 + 2 * (u.pn & 1)) * 16384 + row0 + ai * HALF + m * 16) * 128 + wc * 32 + 8 * fq;
#pragma unroll
                    for (int bj = 0; bj < 2; ++bj) { f32x4 v0 = acc[ai][bj][m][0], v1 = acc[ai][bj][m][1];
                        if (seg == 3) { v0 = silu4(v0); v1 = silu4(v1); }
                        if (seg >= 4) { f32x2 a = gelu_pk((f32x2){v0[0], v0[1]}), b = gelu_pk((f32x2){v0[2], v0[3]}), c = gelu_pk((f32x2){v1[0], v1[1]}), d = gelu_pk((f32x2){v1[2], v1[3]});
                            v0 = (f32x4){a.x, a.y, b.x, b.y}; v1 = (f32x4){c.x, c.y, d.x, d.y}; }
                        u32x4 w; w.x = cvt_pk_bf16(v0[0], v0[1]); w.y = cvt_pk_bf16(v0[2], v0[3]); w.z = cvt_pk_bf16(v1[0], v1[1]); w.w = cvt_pk_bf16(v1[2], v1[3]);
                        *(u32x4*)(rowp + (size_t)bj * 16384 * 128) = w; } }
        }
    }
};
struct EpiRes {
    static constexpr bool PERM = false, AFTER_DRAIN = false;
    const float* X; float* O; float* SSQ;
    __device__ __forceinline__ void operator()(const f32x4 (&acc)[2][2][4][2], const Unit& u, int wr, int wc, int fr, int fq) const {
        const int row0 = u.pm * BM + wr * 64 + fr, col0 = u.pn * BM + wc * 32 + 4 * fq;
#pragma unroll
        for (int ai = 0; ai < 2; ++ai)
#pragma unroll
            for (int m = 0; m < 4; ++m) { const int r = row0 + ai * HALF + m * 16; const size_t off = (size_t)r * 1024 + col0; float ss = 0.f;
#pragma unroll
                for (int bj = 0; bj < 2; ++bj)
#pragma unroll
                    for (int n = 0; n < 2; ++n) { const f32x4 o = *(const f32x4*)(X + off + bj * HALF + n * 16) + acc[ai][bj][m][n];
                        *(f32x4*)(O + off + bj * HALF + n * 16) = o; ss += (o[0] * o[0] + o[1] * o[1]) + (o[2] * o[2] + o[3] * o[3]); }
                ss += __shfl_xor(ss, 16); ss += __shfl_xor(ss, 32);
                if (fq == 0) SSQ[(size_t)r * 16 + u.pn * 4 + wc] = ss;
                asm volatile("" ::: "memory"); }
    }
};
}
namespace pg8 {
struct UnitG : Unit { const char* aB; const char* bB; };
template <class Epi, class Sched>
__device__ __forceinline__ void gemm_phase_g(PG8_LAS unsigned char* lds, const int K, const Sched& S, const Epi& E) {
    const int tid = threadIdx.x, wid = __builtin_amdgcn_readfirstlane(tid >> 6), lane = tid & 63, wr = wid >> 2, wc = wid & 3, fr = lane & 15, fq = lane >> 4;
    const int nt = K / BK;
    unsigned voffB[2];
#pragma unroll
    for (int i = 0; i < 2; ++i) { int R, C; stage_rc(tid * 16 + i * 8192, R, C); const int Rb = Epi::PERM ? ((R & ~31) + perm32(R & 31)) : R;
        voffB[i] = (unsigned)(Rb * K + C) * 2u; }
    const size_t kstep = (size_t)(BK * 2);
    const size_t hstep = (size_t)HALF * K * 2;
    const unsigned ldsw = (unsigned)wid * 1024u;
    const int aoff = lds_byte(wr * 64 + fr, fq * 8), boff = lds_byte(wc * 32 + fr, fq * 8);
#define PG8_SA(b, h) (((b) * 2 + (h)) * HTB)
#define PG8_SB(b, h) ((4 + (b) * 2 + (h)) * HTB)
#define PG8_STAGE(bufoff, gbase, voff) do { _Pragma("unroll") for (int _i = 0; _i < 2; ++_i) \
        __builtin_amdgcn_global_load_lds((const unsigned*)((const char*)(gbase) + (voff)[_i]), (PG8_LAS unsigned*)(lds + (bufoff) + ldsw + _i * 8192), 16, 0, 0); } while (0)
#define PG8_LDA(dst, b, h) do { _Pragma("unroll") for (int m = 0; m < 4; ++m) _Pragma("unroll") for (int k = 0; k < 2; ++k) dst[m][k] = *(const PG8_LAS bf16x8*)(lds + PG8_SA(b, h) + aoff + m * 2048 + k * 1024); } while (0)
#define PG8_LDB(dst, b, h) do { _Pragma("unroll") for (int n = 0; n < 2; ++n) _Pragma("unroll") for (int k = 0; k < 2; ++k) dst[n][k] = *(const PG8_LAS bf16x8*)(lds + PG8_SB(b, h) + boff + n * 2048 + k * 1024); } while (0)
#define PG8_MMA(ai, bj, At, Bt) do { __builtin_amdgcn_s_setprio(1); _Pragma("unroll") for (int m = 0; m < 4; ++m) _Pragma("unroll") for (int n = 0; n < 2; ++n) _Pragma("unroll") for (int k = 0; k < 2; ++k) \
        acc[ai][bj][m][n] = __builtin_amdgcn_mfma_f32_16x16x32_bf16(Bt[n][k], At[m][k], acc[ai][bj][m][n], 0, 0, 0); __builtin_amdgcn_s_setprio(0); } while (0)
#define PG8_WAIT_V(n) asm volatile("s_waitcnt vmcnt(" #n ")" ::: "memory")
#define PG8_WAIT_L(n) asm volatile("s_waitcnt lgkmcnt(" #n ")" ::: "memory")
#define PG8_BAR __builtin_amdgcn_s_barrier()
#define PG8_SCHED __builtin_amdgcn_sched_barrier(0)
    UnitG cur, nxt; int ui = 0;
    if (!S.next(0, cur)) return;
    f32x4 acc[2][2][4][2];
#pragma unroll
    for (int a = 0; a < 2; ++a)
#pragma unroll
        for (int b = 0; b < 2; ++b)
#pragma unroll
            for (int m = 0; m < 4; ++m)
#pragma unroll
                for (int n = 0; n < 2; ++n) acc[a][b][m][n] = (f32x4){0.f, 0.f, 0.f, 0.f};
    bf16x8 At[4][2], B0[2][2], B1[2][2];
    unsigned curA[2][2], nxtA[2][2];
    S.a_offs(cur, tid, curA);
    const char* cA = cur.aB; const char* cB = cur.bB;
    PG8_STAGE(PG8_SB(0, 0), cB, voffB); PG8_STAGE(PG8_SB(0, 1), cB + hstep, voffB); PG8_STAGE(PG8_SA(0, 0), cA, curA[0]); PG8_STAGE(PG8_SA(0, 1), cA, curA[1]);
    if (wr == 1) PG8_BAR;
    PG8_WAIT_V(2); PG8_BAR;
    PG8_STAGE(PG8_SB(1, 0), cB + kstep, voffB); PG8_STAGE(PG8_SA(1, 0), cA + kstep, curA[0]); PG8_STAGE(PG8_SB(1, 1), cB + hstep + kstep, voffB);
    PG8_WAIT_V(6); PG8_BAR;
    for (;;) {
        const bool has_next = S.next(ui + 1, nxt);
        if (has_next) S.a_offs(nxt, tid, nxtA);
        else {
#pragma unroll
            for (int h = 0; h < 2; ++h)
#pragma unroll
                for (int i = 0; i < 2; ++i) nxtA[h][i] = curA[h][i]; }
        const char* nA = has_next ? nxt.aB : cA; const char* nB = has_next ? nxt.bB : cB;
#pragma unroll 1
        for (int t = 0; t < nt; t += 2) {
            const bool last = (t == nt - 2);
            const char* a1 = cA + (size_t)(t + 1) * kstep;
            const char* a2 = last ? nA : cA + (size_t)(t + 2) * kstep; const char* b2 = last ? nB : cB + (size_t)(t + 2) * kstep;
            const char* a3 = a2 + kstep; const char* b3 = b2 + kstep;
            unsigned oa2[2][2];
#pragma unroll
            for (int h = 0; h < 2; ++h)
#pragma unroll
                for (int i = 0; i < 2; ++i) oa2[h][i] = last ? nxtA[h][i] : curA[h][i];
            PG8_LDB(B0, 0, 0); PG8_LDB(B1, 0, 1); PG8_SCHED; PG8_LDA(At, 0, 0); PG8_STAGE(PG8_SA(1, 1), a1, curA[1]);
            PG8_WAIT_V(8); PG8_WAIT_L(0); PG8_BAR; PG8_MMA(0, 0, At, B0); PG8_MMA(0, 1, At, B1); PG8_BAR; PG8_SCHED;
            PG8_LDA(At, 0, 1); PG8_STAGE(PG8_SB(0, 0), b2, voffB); PG8_STAGE(PG8_SB(0, 1), b2 + hstep, voffB); PG8_STAGE(PG8_SA(0, 0), a2, oa2[0]);
            PG8_WAIT_V(8); PG8_WAIT_L(0); PG8_BAR; PG8_MMA(1, 0, At, B0); PG8_MMA(1, 1, At, B1); PG8_BAR; PG8_SCHED;
            PG8_LDB(B0, 1, 0); PG8_LDB(B1, 1, 1); PG8_SCHED; PG8_LDA(At, 1, 0); PG8_STAGE(PG8_SA(0, 1), a2, oa2[1]);
            PG8_WAIT_V(8); PG8_WAIT_L(0); PG8_BAR; PG8_MMA(0, 0, At, B0); PG8_MMA(0, 1, At, B1); PG8_BAR; PG8_SCHED;
            PG8_LDA(At, 1, 1); PG8_STAGE(PG8_SB(1, 0), b3, voffB); PG8_STAGE(PG8_SB(1, 1), b3 + hstep, voffB); PG8_STAGE(PG8_SA(1, 0), a3, oa2[0]);
            PG8_WAIT_V(8); PG8_WAIT_L(0); PG8_BAR; PG8_MMA(1, 0, At, B0); PG8_MMA(1, 1, At, B1); PG8_BAR; PG8_SCHED;
        }
        if (wr == 0) PG8_BAR;
        E(acc, cur, wr, wc, fr, fq);
        if (!has_next) break;
#pragma unroll
        for (int a = 0; a < 2; ++a)
#pragma unroll
            for (int b = 0; b < 2; ++b)
#pragma unroll
                for (int m = 0; m < 4; ++m)
#pragma unroll
                    for (int n = 0; n < 2; ++n) acc[a][b][m][n] = (f32x4){0.f, 0.f, 0.f, 0.f};
        cur = nxt; cA = nA; cB = nB; ++ui;
#pragma unroll
        for (int h = 0; h < 2; ++h)
#pragma unroll
            for (int i = 0; i < 2; ++i) curA[h][i] = nxtA[h][i];
        if (wr == 1) PG8_BAR;
    }
    PG8_WAIT_V(0);
    PG8_BAR;
#undef PG8_SA
#undef PG8_SB
#undef PG8_STAGE
#undef PG8_LDA
#undef PG8_LDB
#undef PG8_MMA
#undef PG8_WAIT_V
#undef PG8_WAIT_L
#undef PG8_BAR
#undef PG8_SCHED
}

struct MoeASched {
    const int* TILE; const int* ETOK; const char* H2; const char* WGU; int G, c;
    __device__ __forceinline__ bool next(int i, UnitG& u) const {
        const int L = i * G + c, nt = TILE[0]; if (L >= nt * 2) return false;
        const int ti = L >> 1, pn = L & 1, e = TILE[1 + ti];
        u.pm = ti; u.pn = pn; u.aB = H2; u.bB = WGU + ((size_t)e * 512 + pn * 256) * 2048; return true; }
    __device__ __forceinline__ void a_offs(const UnitG& u, int tid, unsigned (&o)[2][2]) const {
#pragma unroll
        for (int i = 0; i < 2; ++i) { int R, C; stage_rc(tid * 16 + i * 8192, R, C);
#pragma unroll
            for (int h = 0; h < 2; ++h) o[h][i] = (unsigned)ETOK[u.pm * 256 + h * 128 + R] * 2048u + (unsigned)C * 2u; } }
};
struct MoeBSched {
    const int* TILE; const char* ACT; const char* WDN; int G, c;
    __device__ __forceinline__ bool next(int i, UnitG& u) const {
        const int L = i * G + c, nt = TILE[0]; if (L >= nt * 4) return false;
        const int ti = L >> 2, pn = L & 3, e = TILE[1 + ti];
        u.pm = ti; u.pn = pn; u.aB = ACT + (size_t)ti * 256 * 512; u.bB = WDN + ((size_t)e * 1024 + pn * 256) * 512; return true; }
    __device__ __forceinline__ void a_offs(const UnitG&, int tid, unsigned (&o)[2][2]) const {
#pragma unroll
        for (int i = 0; i < 2; ++i) { int R, C; stage_rc(tid * 16 + i * 8192, R, C);
#pragma unroll
            for (int h = 0; h < 2; ++h) o[h][i] = (unsigned)((h * 128 + R) * 256 + C) * 2u; } }
};
struct EpiAct {
    static constexpr bool PERM = true, AFTER_DRAIN = false;
    bf16_t* ACT; const float* EW;
    __device__ __forceinline__ void operator()(const f32x4 (&acc)[2][2][4][2], const UnitG& u, int wr, int wc, int fr, int fq) const {
        const int row0 = u.pm * BM + wr * 64 + fr;
#pragma unroll
        for (int ai = 0; ai < 2; ++ai)
#pragma unroll
            for (int m = 0; m < 4; ++m) { const int r = row0 + ai * HALF + m * 16; const float w = EW[r];
                const f32x4 v0 = silu4(acc[ai][0][m][0]) * acc[ai][1][m][0] * w, v1 = silu4(acc[ai][0][m][1]) * acc[ai][1][m][1] * w;
                u32x4 o; o.x = cvt_pk_bf16(v0[0], v0[1]); o.y = cvt_pk_bf16(v0[2], v0[3]); o.z = cvt_pk_bf16(v1[0], v1[1]); o.w = cvt_pk_bf16(v1[2], v1[3]);
                *(u32x4*)(ACT + (size_t)r * 256 + u.pn * 128 + wc * 32 + 8 * fq) = o; }
    }
};
struct EpiYE {
    static constexpr bool PERM = true, AFTER_DRAIN = false;
    bf16_t* YE;
    __device__ __forceinline__ void operator()(const f32x4 (&acc)[2][2][4][2], const UnitG& u, int wr, int wc, int fr, int fq) const {
        const int row0 = u.pm * BM + wr * 64 + fr;
#pragma unroll
        for (int ai = 0; ai < 2; ++ai)
#pragma unroll
            for (int m = 0; m < 4; ++m) { bf16_t* rowp = YE + (size_t)(row0 + ai * HALF + m * 16) * 1024 + u.pn * BM + wc * 32 + 8 * fq;
#pragma unroll
                for (int bj = 0; bj < 2; ++bj) { const f32x4 v0 = acc[ai][bj][m][0], v1 = acc[ai][bj][m][1];
                    u32x4 o; o.x = cvt_pk_bf16(v0[0], v0[1]); o.y = cvt_pk_bf16(v0[2], v0[3]); o.z = cvt_pk_bf16(v1[0], v1[1]); o.w = cvt_pk_bf16(v1[2], v1[3]);
                    *(u32x4*)(rowp + bj * HALF) = o; } }
    }
};
}
namespace tl {
typedef short bf16x8 __attribute__((ext_vector_type(8)));
typedef short s16x4 __attribute__((ext_vector_type(4)));
typedef float f32x4 __attribute__((ext_vector_type(4)));
typedef unsigned u32x4 __attribute__((ext_vector_type(4)));
typedef unsigned u32x2 __attribute__((ext_vector_type(2)));
constexpr int TILE_BYTES = 32768;
constexpr int STAT_OFF = 131072 + 1024;
__device__ __forceinline__ unsigned off_b(unsigned row, unsigned ch) { return 256u * row + 16u * (ch ^ (((row & 3u) << 2) | ((row >> 2) & 3u))); }
__device__ __forceinline__ unsigned cvtpk(float lo, float hi) { unsigned r; asm volatile("v_cvt_pk_bf16_f32 %0, %1, %2" : "=v"(r) : "v"(lo), "v"(hi)); return r; }
__device__ __forceinline__ float blo(unsigned w) { return __uint_as_float(w << 16); }
__device__ __forceinline__ float bhi(unsigned w) { return __uint_as_float(w & 0xffff0000u); }

__device__ __forceinline__ void stage_plain(LAS unsigned char* tile, const bf16* g, size_t ld, int tid) {
#pragma unroll
    for (int i = 0; i < 4; ++i) { const int idx = tid + 512 * i, row = idx >> 4, ch = idx & 15;
        const u32x4 v = *(const u32x4*)(g + (size_t)row * ld + ch * 8);
        *(LAS u32x4*)(tile + off_b(row, ch)) = v; }
}
__device__ __forceinline__ u32x4 scale8(u32x4 v, float s) {
    u32x4 o; o.x = cvtpk(blo(v.x) * s, bhi(v.x) * s); o.y = cvtpk(blo(v.y) * s, bhi(v.y) * s); o.z = cvtpk(blo(v.z) * s, bhi(v.z) * s); o.w = cvtpk(blo(v.w) * s, bhi(v.w) * s); return o;
}
__device__ __forceinline__ void stage_decay(LAS unsigned char* tile, const bf16* g, size_t ld, int tid, float l2g) {
#pragma unroll
    for (int i = 0; i < 4; ++i) { const int idx = tid + 512 * i, row = idx >> 4, ch = idx & 15;
        const u32x4 v = *(const u32x4*)(g + (size_t)row * ld + ch * 8);
        *(LAS u32x4*)(tile + off_b(row, ch)) = scale8(v, exp2f((float)(127 - row) * l2g)); }
}
__device__ __forceinline__ void stage_rmsrow(LAS unsigned char* tile, const bf16* g, size_t ld, int tid) {
#pragma unroll
    for (int i = 0; i < 4; ++i) { const int idx = tid + 512 * i, row = idx >> 4, ch = idx & 15;
        const u32x4 v = *(const u32x4*)(g + (size_t)row * ld + ch * 8);
        float ss = (blo(v.x) * blo(v.x) + bhi(v.x) * bhi(v.x)) + (blo(v.y) * blo(v.y) + bhi(v.y) * bhi(v.y)) + (blo(v.z) * blo(v.z) + bhi(v.z) * bhi(v.z)) + (blo(v.w) * blo(v.w) + bhi(v.w) * bhi(v.w));
        ss += __shfl_xor(ss, 1); ss += __shfl_xor(ss, 2); ss += __shfl_xor(ss, 4); ss += __shfl_xor(ss, 8);
        *(LAS u32x4*)(tile + off_b(row, ch)) = scale8(v, 1.0f / sqrtf(ss * (1.0f / 128.0f) + EPS)); }
}
template <int NB> __device__ __forceinline__ void ld_row(const LAS unsigned char* tile, int rowbase, int fr, int fq, bf16x8 (&f)[NB][4]) {
#pragma unroll
    for (int i = 0; i < NB; ++i)
#pragma unroll
        for (int s = 0; s < 4; ++s) f[i][s] = *(const LAS bf16x8*)(tile + off_b(rowbase + 16 * i + fr, 4 * s + fq));
}
__device__ __forceinline__ void ld_tr(const LAS unsigned char* tile, int c, int lane, bf16x8 (&f)[4]) {
    const unsigned g = lane >> 4, q = (lane & 15) >> 2, p = lane & 3;
    const unsigned base = (unsigned)(size_t)tile;
    const unsigned a0 = base + off_b(8 * g + q, 2 * c + (p >> 1)) + 8 * (p & 1);
    const unsigned a1 = base + off_b(8 * g + 4 + q, 2 * c + (p >> 1)) + 8 * (p & 1);
    s16x4 l0, h0, l1, h1, l2, h2, l3, h3;
    asm volatile("ds_read_b64_tr_b16 %0, %8\n\tds_read_b64_tr_b16 %1, %9\n\t"
                 "ds_read_b64_tr_b16 %2, %8 offset:8192\n\tds_read_b64_tr_b16 %3, %9 offset:8192\n\t"
                 "ds_read_b64_tr_b16 %4, %8 offset:16384\n\tds_read_b64_tr_b16 %5, %9 offset:16384\n\t"
                 "ds_read_b64_tr_b16 %6, %8 offset:24576\n\tds_read_b64_tr_b16 %7, %9 offset:24576\n\t"
                 "s_waitcnt lgkmcnt(0)"
                 : "=&v"(l0), "=&v"(h0), "=&v"(l1), "=&v"(h1), "=&v"(l2), "=&v"(h2), "=&v"(l3), "=&v"(h3) : "v"(a0), "v"(a1) : "memory");
    f[0] = __builtin_shufflevector(l0, h0, 0, 1, 2, 3, 4, 5, 6, 7); f[1] = __builtin_shufflevector(l1, h1, 0, 1, 2, 3, 4, 5, 6, 7);
    f[2] = __builtin_shufflevector(l2, h2, 0, 1, 2, 3, 4, 5, 6, 7); f[3] = __builtin_shufflevector(l3, h3, 0, 1, 2, 3, 4, 5, 6, 7);
}
__device__ __forceinline__ void mma(f32x4 (&acc)[4][2], const bf16x8 (&A)[4][4], const bf16x8 (&B)[2][4]) {
#pragma unroll
    for (int s = 0; s < 4; ++s)
#pragma unroll
        for (int m = 0; m < 4; ++m)
#pragma unroll
            for (int n = 0; n < 2; ++n) acc[m][n] = __builtin_amdgcn_mfma_f32_16x16x32_bf16(B[n][s], A[m][s], acc[m][n], 0, 0, 0);
}
__device__ __forceinline__ void zero(f32x4 (&acc)[4][2]) {
#pragma unroll
    for (int m = 0; m < 4; ++m)
#pragma unroll
        for (int n = 0; n < 2; ++n) acc[m][n] = (f32x4){0.f, 0.f, 0.f, 0.f};
}

#define TL_BAR() do { asm volatile("s_waitcnt lgkmcnt(0)" ::: "memory"); __builtin_amdgcn_s_barrier(); asm volatile("" ::: "memory"); } while (0)
__device__ __forceinline__ void pf_tile(u32x4 (&r)[4], const bf16* g, int tid) {
#pragma unroll
    for (int i = 0; i < 4; ++i) r[i] = *(const u32x4*)(g + (size_t)(tid + 512 * i) * 8);
}
template <int NB> __device__ __forceinline__ void ldg_row(const bf16* g, int rowbase, int fr, int fq, bf16x8 (&f)[NB][4]) {
#pragma unroll
    for (int i = 0; i < NB; ++i)
#pragma unroll
        for (int s = 0; s < 4; ++s) f[i][s] = *(const bf16x8*)(g + (size_t)(rowbase + 16 * i + fr) * 128 + 32 * s + 8 * fq);
}

__device__ __forceinline__ void phase_kv(LAS unsigned char* lds, const bf16* PROJ, float* KVT, int bid, int G) {
    const int tid = threadIdx.x, lane = tid & 63, wid = __builtin_amdgcn_readfirstlane(tid >> 6), wr = wid >> 2, wc = wid & 3, fr = lane & 15, fq = lane >> 4;
    int u = bid; if (u >= 512) return;
    u32x4 pk[4], pv[4];
    { const int h = u & 3; const size_t t0 = (size_t)(u >> 8) * S_ + (size_t)((u >> 2) & 63) * CH;
      pf_tile(pk, PROJ + ((size_t)(4 + h) * T_ + t0) * 128, tid); pf_tile(pv, PROJ + ((size_t)(8 + h) * T_ + t0) * 128, tid); }
    int par = 0;
    for (;;) {
        LAS unsigned char* tK = lds + par * 2 * TILE_BYTES; LAS unsigned char* tV = tK + TILE_BYTES;
        const float l2g = log2_gamma(u & 3);
#pragma unroll
        for (int i = 0; i < 4; ++i) { const int idx = tid + 512 * i, row = idx >> 4, ch = idx & 15;
            *(LAS u32x4*)(tK + off_b(row, ch)) = scale8(pk[i], exp2f((float)(127 - row) * l2g));
            *(LAS u32x4*)(tV + off_b(row, ch)) = pv[i]; }
        TL_BAR();
        const int un = u + G; const bool has_next = un < 512;
        if (has_next) { const int h = un & 3; const size_t t0 = (size_t)(un >> 8) * S_ + (size_t)((un >> 2) & 63) * CH;
            pf_tile(pk, PROJ + ((size_t)(4 + h) * T_ + t0) * 128, tid); pf_tile(pv, PROJ + ((size_t)(8 + h) * T_ + t0) * 128, tid); }
        bf16x8 A[4][4], Bf[2][4];
#pragma unroll
        for (int m = 0; m < 4; ++m) ld_tr(tV, 4 * wr + m, lane, A[m]);
#pragma unroll
        for (int nn = 0; nn < 2; ++nn) ld_tr(tK, 2 * wc + nn, lane, Bf[nn]);
        f32x4 acc[4][2]; zero(acc); mma(acc, A, Bf);
        float* o = KVT + (size_t)u * 16384;
#pragma unroll
        for (int m = 0; m < 4; ++m)
#pragma unroll
            for (int nn = 0; nn < 2; ++nn) *(f32x4*)(o + (64 * wr + 16 * m + fr) * 128 + 32 * wc + 16 * nn + 4 * fq) = acc[m][nn];
        if (!has_next) break;
        u = un; par ^= 1;
    }
    TL_BAR();
}
__device__ __forceinline__ void phase_sgu(LAS unsigned char* lds, const bf16* PROJ, const bf16* WSM, const float* bs, const float* gain, bf16* MIX, int bid, int G) {
    const int tid = threadIdx.x, lane = tid & 63, wid = __builtin_amdgcn_readfirstlane(tid >> 6), wr = wid >> 2, wc = wid & 3, fr = lane & 15, fq = lane >> 4;
    int u = bid; if (u >= 512) return;
    u32x4 pv[4]; u32x2 uu[4][2];
    { const int g = u & 3; const size_t t0 = (size_t)(u >> 8) * S_ + (size_t)((u >> 2) & 63) * CH;
      pf_tile(pv, PROJ + ((size_t)(20 + g) * T_ + t0) * 128, tid);
#pragma unroll
      for (int m = 0; m < 4; ++m)
#pragma unroll
          for (int nn = 0; nn < 2; ++nn) uu[m][nn] = *(const u32x2*)(PROJ + ((size_t)(16 + g) * T_ + t0 + 64 * wr + 16 * m + fr) * 128 + 32 * wc + 16 * nn + 4 * fq); }
    int par = 0, gcur = -1;
    bf16x8 A[4][4]; f32x4 gn[2]; float bi[4];
    for (;;) {
        LAS unsigned char* tV = lds + par * TILE_BYTES;
        const int g = u & 3; const size_t t0 = (size_t)(u >> 8) * S_ + (size_t)((u >> 2) & 63) * CH;
        if (g != gcur) {
            gcur = g; ldg_row<4>(WSM + (size_t)g * 16384, 64 * wr, fr, fq, A);
#pragma unroll
            for (int nn = 0; nn < 2; ++nn) gn[nn] = *(const f32x4*)(gain + g * 128 + 32 * wc + 16 * nn + 4 * fq);
#pragma unroll
            for (int m = 0; m < 4; ++m) bi[m] = bs[g * 128 + 64 * wr + 16 * m + fr];
        }
#pragma unroll
        for (int i = 0; i < 4; ++i) { const int idx = tid + 512 * i, row = idx >> 4, ch = idx & 15; const u32x4 v = pv[i];
            float ss = (blo(v.x) * blo(v.x) + bhi(v.x) * bhi(v.x)) + (blo(v.y) * blo(v.y) + bhi(v.y) * bhi(v.y)) + (blo(v.z) * blo(v.z) + bhi(v.z) * bhi(v.z)) + (blo(v.w) * blo(v.w) + bhi(v.w) * bhi(v.w));
            ss += __shfl_xor(ss, 1); ss += __shfl_xor(ss, 2); ss += __shfl_xor(ss, 4); ss += __shfl_xor(ss, 8);
            *(LAS u32x4*)(tV + off_b(row, ch)) = scale8(v, 1.0f / sqrtf(ss * (1.0f / 128.0f) + EPS)); }
        TL_BAR();
        u32x2 uc[4][2];
#pragma unroll
        for (int m = 0; m < 4; ++m)
#pragma unroll
            for (int nn = 0; nn < 2; ++nn) uc[m][nn] = uu[m][nn];
        const int un = u + G; const bool has_next = un < 512;
        if (has_next) { const int g2 = un & 3; const size_t t2 = (size_t)(un >> 8) * S_ + (size_t)((un >> 2) & 63) * CH;
            pf_tile(pv, PROJ + ((size_t)(20 + g2) * T_ + t2) * 128, tid);
#pragma unroll
            for (int m = 0; m < 4; ++m)
#pragma unroll
                for (int nn = 0; nn < 2; ++nn) uu[m][nn] = *(const u32x2*)(PROJ + ((size_t)(16 + g2) * T_ + t2 + 64 * wr + 16 * m + fr) * 128 + 32 * wc + 16 * nn + 4 * fq); }
        bf16x8 Bf[2][4];
#pragma unroll
        for (int nn = 0; nn < 2; ++nn) ld_tr(tV, 2 * wc + nn, lane, Bf[nn]);
        f32x4 acc[4][2]; zero(acc); mma(acc, A, Bf);
#pragma unroll
        for (int m = 0; m < 4; ++m) { const int i = 64 * wr + 16 * m + fr;
#pragma unroll
            for (int nn = 0; nn < 2; ++nn) { const int c = 32 * wc + 16 * nn + 4 * fq;
                const f32x4 sv = acc[m][nn] * gn[nn] + bi[m];
                u32x2 o; o.x = cvtpk(blo(uc[m][nn].x) * sv[0], bhi(uc[m][nn].x) * sv[1]); o.y = cvtpk(blo(uc[m][nn].y) * sv[2], bhi(uc[m][nn].y) * sv[3]);
                *(u32x2*)(MIX + (t0 + i) * D_ + 512 + g * 128 + c) = o; } }
        if (!has_next) break;
        u = un; par ^= 1;
    }
    TL_BAR();
}
__device__ __forceinline__ void phase_ret(LAS unsigned char* lds, const bf16* PROJ, const bf16* ST, const float* gn_gain, bf16* MIX, int bid, int G) {
    const int tid = threadIdx.x, lane = tid & 63, wid = __builtin_amdgcn_readfirstlane(tid >> 6), wr = wid >> 2, wc = wid & 3, fr = lane & 15, fq = lane >> 4;
    int u = bid; if (u >= 512) return;
    u32x4 pv[4];
    { const int h = u & 3; const size_t t0 = (size_t)(u >> 8) * S_ + (size_t)((u >> 2) & 63) * CH; pf_tile(pv, PROJ + ((size_t)(8 + h) * T_ + t0) * 128, tid); }
    int par = 0;
    for (;;) {
        LAS unsigned char* tV = lds + par * 2 * TILE_BYTES; LAS unsigned char* tP = tV + TILE_BYTES;
        LAS float* stat = (LAS float*)(lds + 4 * TILE_BYTES + 1024 + par * 4096);
        const int h = u & 3; const size_t t0 = (size_t)(u >> 8) * S_ + (size_t)((u >> 2) & 63) * CH;
        const float l2g = log2_gamma(h);
        bf16x8 A[4][4], Bs[2][4], Bk[2][4];
        ldg_row<4>(PROJ + ((size_t)(0 + h) * T_ + t0) * 128, 64 * wr, fr, fq, A);
        ldg_row<2>(ST + (size_t)u * 16384, 32 * wc, fr, fq, Bs);
        ldg_row<2>(PROJ + ((size_t)(4 + h) * T_ + t0) * 128, 32 * wc, fr, fq, Bk);
#pragma unroll
        for (int i = 0; i < 4; ++i) { const int idx = tid + 512 * i; *(LAS u32x4*)(tV + off_b(idx >> 4, idx & 15)) = pv[i]; }
        { f32x4 accS[4][2]; zero(accS); mma(accS, A, Bk);
#pragma unroll
          for (int m = 0; m < 4; ++m) { const int i = 64 * wr + 16 * m + fr;
#pragma unroll
              for (int nn = 0; nn < 2; ++nn) { const int j0 = 32 * wc + 16 * nn + 4 * fq; float pvv[4];
#pragma unroll
                  for (int v = 0; v < 4; ++v) { const int dd = i - (j0 + v); pvv[v] = dd >= 0 ? accS[m][nn][v] * exp2f((float)dd * l2g) : 0.f; }
                  u32x2 o; o.x = cvtpk(pvv[0], pvv[1]); o.y = cvtpk(pvv[2], pvv[3]);
                  *(LAS u32x2*)(tP + off_b(i, 4 * wc + 2 * nn + (fq >> 1)) + 8 * (fq & 1)) = o; } } }
        f32x4 accO[4][2]; zero(accO); mma(accO, A, Bs);
#pragma unroll
        for (int m = 0; m < 4; ++m) { const float qd = exp2f((float)(64 * wr + 16 * m + fr + 1) * l2g);
#pragma unroll
            for (int nn = 0; nn < 2; ++nn) accO[m][nn] *= qd; }
        TL_BAR();
        const int un = u + G; const bool has_next = un < 512;
        if (has_next) { const int h2 = un & 3; const size_t t2 = (size_t)(un >> 8) * S_ + (size_t)((un >> 2) & 63) * CH; pf_tile(pv, PROJ + ((size_t)(8 + h2) * T_ + t2) * 128, tid); }
        u32x2 gt[4][2]; f32x4 gg[2];
#pragma unroll
        for (int nn = 0; nn < 2; ++nn) gg[nn] = *(const f32x4*)(gn_gain + h * 128 + 32 * wc + 16 * nn + 4 * fq);
#pragma unroll
        for (int m = 0; m < 4; ++m)
#pragma unroll
            for (int nn = 0; nn < 2; ++nn) gt[m][nn] = *(const u32x2*)(PROJ + ((size_t)(12 + h) * T_ + t0 + 64 * wr + 16 * m + fr) * 128 + 32 * wc + 16 * nn + 4 * fq);
        ld_row<4>(tP, 64 * wr, fr, fq, A);
#pragma unroll
        for (int nn = 0; nn < 2; ++nn) ld_tr(tV, 2 * wc + nn, lane, Bs[nn]);
        mma(accO, A, Bs);
#pragma unroll
        for (int m = 0; m < 4; ++m) { float sm = 0.f, q = 0.f;
#pragma unroll
            for (int nn = 0; nn < 2; ++nn) { const f32x4 x = accO[m][nn]; sm += (x[0] + x[1]) + (x[2] + x[3]); q += (x[0] * x[0] + x[1] * x[1]) + (x[2] * x[2] + x[3] * x[3]); }
            sm += __shfl_xor(sm, 16); sm += __shfl_xor(sm, 32); q += __shfl_xor(q, 16); q += __shfl_xor(q, 32);
            if (fq == 0) { const int i = 64 * wr + 16 * m + fr; stat[(i * 4 + wc) * 2] = sm; stat[(i * 4 + wc) * 2 + 1] = q; } }
        TL_BAR();
#pragma unroll
        for (int m = 0; m < 4; ++m) { const int i = 64 * wr + 16 * m + fr;
            const f32x4 p0 = *(const LAS f32x4*)(stat + i * 8), p1 = *(const LAS f32x4*)(stat + i * 8 + 4);
            const float mu = ((p0[0] + p0[2]) + (p1[0] + p1[2])) * (1.0f / 128.0f);
            const float var = fmaxf(((p0[1] + p0[3]) + (p1[1] + p1[3])) * (1.0f / 128.0f) - mu * mu, 0.f);
            const float rstd = 1.0f / sqrtf(var + EPS);
#pragma unroll
            for (int nn = 0; nn < 2; ++nn) { const int e = 32 * wc + 16 * nn + 4 * fq;
                const f32x4 y = (accO[m][nn] - mu) * rstd * gg[nn];
                u32x2 o; o.x = cvtpk(y[0] * blo(gt[m][nn].x), y[1] * bhi(gt[m][nn].x)); o.y = cvtpk(y[2] * blo(gt[m][nn].y), y[3] * bhi(gt[m][nn].y));
                *(u32x2*)(MIX + (t0 + i) * D_ + h * 128 + e) = o; } }
        if (!has_next) break;
        u = un; par ^= 1;
    }
    TL_BAR();
}
#undef TL_BAR
}
namespace rt {
typedef short bf16x8 __attribute__((ext_vector_type(8)));
typedef float f32x4 __attribute__((ext_vector_type(4)));
typedef unsigned u32x4 __attribute__((ext_vector_type(4)));
constexpr int PSTR = 49;
__device__ __forceinline__ void ph_router(LAS unsigned char* lds, const float* X1, const float* SSQ, const float* gain, const bf16* WRT, const float* brg, const float* bre,
                                          bf16* H2, int4* ROUTE, int* CNT, int bid, int nblk) {
    const int tid = threadIdx.x, lane = tid & 63, wid = __builtin_amdgcn_readfirstlane(tid >> 6), fr = lane & 15, fq = lane >> 4;
    const int rb = wid & 3, kh = wid >> 2;
    LAS float* part = (LAS float*)lds;
    for (int c = bid; c < T_ / 64; c += nblk) {
        const int row = c * 64 + 16 * rb + fr;
        float ss = 0.f;
        { const f32x4* sp = (const f32x4*)(SSQ + (size_t)row * 16);
#pragma unroll
          for (int i = 0; i < 4; ++i) { const f32x4 v = sp[i]; ss += (v[0] + v[1]) + (v[2] + v[3]); } }
        const float rstd = 1.0f / sqrtf(ss * (1.0f / D_) + EPS);
        f32x4 acc[3];
#pragma unroll
        for (int i = 0; i < 3; ++i) acc[i] = (f32x4){0.f, 0.f, 0.f, 0.f};
        const float* xr = X1 + (size_t)row * D_ + 512 * kh + 8 * fq;
        const float* gr = gain + 512 * kh + 8 * fq;
        const bf16* wr0 = WRT + (size_t)fr * D_ + 512 * kh + 8 * fq;
        bf16* hr = H2 + (size_t)row * D_ + 512 * kh + 8 * fq;
#pragma unroll 8
        for (int kc = 0; kc < 16; ++kc) {
            const f32x4 x0 = *(const f32x4*)(xr + 32 * kc), x1 = *(const f32x4*)(xr + 32 * kc + 4);
            const f32x4 g0 = *(const f32x4*)(gr + 32 * kc), g1 = *(const f32x4*)(gr + 32 * kc + 4);
            bf16x8 bh[3], bl[3];
#pragma unroll
            for (int nt = 0; nt < 3; ++nt) { bh[nt] = *(const bf16x8*)(wr0 + (size_t)(16 * nt) * D_ + 32 * kc); bl[nt] = *(const bf16x8*)(wr0 + (size_t)(48 + 16 * nt) * D_ + 32 * kc); }
            float hn[8];
#pragma unroll
            for (int j = 0; j < 4; ++j) { hn[j] = x0[j] * rstd * g0[j]; hn[4 + j] = x1[j] * rstd * g1[j]; }
            u32x4 hi, lo;
            hi.x = pk2(hn[0], hn[1]); hi.y = pk2(hn[2], hn[3]); hi.z = pk2(hn[4], hn[5]); hi.w = pk2(hn[6], hn[7]);
            lo.x = pk2(hn[0] - __uint_as_float(hi.x << 16), hn[1] - __uint_as_float(hi.x & 0xffff0000u));
            lo.y = pk2(hn[2] - __uint_as_float(hi.y << 16), hn[3] - __uint_as_float(hi.y & 0xffff0000u));
            lo.z = pk2(hn[4] - __uint_as_float(hi.z << 16), hn[5] - __uint_as_float(hi.z & 0xffff0000u));
            lo.w = pk2(hn[6] - __uint_as_float(hi.w << 16), hn[7] - __uint_as_float(hi.w & 0xffff0000u));
            *(u32x4*)(hr + 32 * kc) = hi;
            const bf16x8 ah = __builtin_bit_cast(bf16x8, hi), al = __builtin_bit_cast(bf16x8, lo);
#pragma unroll
            for (int nt = 0; nt < 3; ++nt) {
                acc[nt] = __builtin_amdgcn_mfma_f32_16x16x32_bf16(bh[nt], ah, acc[nt], 0, 0, 0);
                acc[nt] = __builtin_amdgcn_mfma_f32_16x16x32_bf16(bh[nt], al, acc[nt], 0, 0, 0);
                acc[nt] = __builtin_amdgcn_mfma_f32_16x16x32_bf16(bl[nt], ah, acc[nt], 0, 0, 0);
            }
        }
#pragma unroll
        for (int nt = 0; nt < 3; ++nt)
#pragma unroll
            for (int v = 0; v < 4; ++v) part[(kh * 64 + 16 * rb + fr) * PSTR + 16 * nt + 4 * fq + v] = acc[nt][v];
        __syncthreads();
        if (wid == 0) {
            const LAS float* p0 = part + lane * PSTR; const LAS float* p1 = part + (64 + lane) * PSTR;
            float lg[4], le[4][8];
#pragma unroll
            for (int g = 0; g < 4; ++g) { lg[g] = p0[32 + g] + p1[32 + g] + brg[g];
#pragma unroll
                for (int e = 0; e < 8; ++e) le[g][e] = p0[g * 8 + e] + p1[g * 8 + e] + bre[g * 8 + e]; }
            int e1, e2; float w1, w2; route_decide(lg, le, e1, e2, w1, w2);
            int r1 = 0, r2 = 0, mycnt = 0;
            const unsigned long long lt = (1ull << lane) - 1ull;
            for (int e = 0; e < NEXP; ++e) {
                const unsigned long long m = __ballot(e1 == e || e2 == e);
                const int below = __popcll(m & lt);
                if (e1 == e) r1 = below;
                if (e2 == e) r2 = below;
                if (lane == e) mycnt = __popcll(m);
            }
            ROUTE[c * 64 + lane] = make_int4(e1 | (r1 << 8), e2 | (r2 << 8), __float_as_int(w1), __float_as_int(w2));
            if (lane < NEXP) CNT[c * NEXP + lane] = mycnt;
        }
        __syncthreads();
    }
}
}
#define XB_TMO      128
#define XB_XCNT(j)  (256  + 64 * (j))
#define XB_XSUB(j)  (1280 + 64 * (j))
#define XB_XGEN(j)  (2304 + 64 * (j))
#define XB_TOP      3328
#define XB_TOPGEN   3392
#define XCD_BAR_WORDS 3456
#define XB_SPIN_CAP (1u << 18)

__device__ __forceinline__ unsigned xb_ld(unsigned* p)              { return __hip_atomic_load(p, __ATOMIC_RELAXED, __HIP_MEMORY_SCOPE_AGENT); }
__device__ __forceinline__ unsigned xb_add(unsigned* p, unsigned v) { return __hip_atomic_fetch_add(p, v, __ATOMIC_RELAXED, __HIP_MEMORY_SCOPE_AGENT); }
__device__ __forceinline__ unsigned xb_xcc_id() { return (unsigned)__builtin_amdgcn_s_getreg((3 << 11) | 20) & 0xFu; }
#define XB_SPIN(cond, bar) do { unsigned _sp = 0; while (cond) { __builtin_amdgcn_s_sleep(1); \
    if ((++_sp & 255u) == 0u) { if (xb_ld(&(bar)[XB_TMO])) break; if (_sp > XB_SPIN_CAP) { atomicAdd(&(bar)[XB_TMO], 1u); break; } } } } while (0)

struct XcdBarrier {
    unsigned* bar; unsigned x;
    volatile LAS unsigned* st;
};

__device__ __forceinline__ XcdBarrier xcd_barrier_post(unsigned* bar, volatile LAS unsigned* st) {
    XcdBarrier b; b.bar = bar; b.x = xb_xcc_id(); b.st = st;
    if (threadIdx.x == 0) (void)xb_add(&bar[XB_XCNT(b.x)], 1u);
    return b;
}
__device__ __forceinline__ void xcd_barrier_complete(unsigned* bar, unsigned x, unsigned& nloc, unsigned& nx) {
    const unsigned G = gridDim.x * gridDim.y * gridDim.z;
    unsigned sum, cnt, mine, sp = 0u;
    for (;;) {
        sum = 0u; cnt = 0u; mine = 0u;
#pragma unroll
        for (unsigned j = 0; j < 16; ++j) { const unsigned c = xb_ld(&bar[XB_XCNT(j)]); sum += c; cnt += (c > 0u) ? 1u : 0u; mine = (j == x) ? c : mine; }
        if (sum == G) break;
        __builtin_amdgcn_s_sleep(1);
        if ((++sp & 255u) == 0u) { if (xb_ld(&bar[XB_TMO])) break; if (sp > XB_SPIN_CAP) { atomicAdd(&bar[XB_TMO], 1u); break; } }
    }
    nloc = mine > 0u ? mine : 1u; nx = cnt > 0u ? cnt : 1u;
}

__device__ __forceinline__ void xcd_barrier(const XcdBarrier& b) {
    asm volatile("s_waitcnt vmcnt(0)" ::: "memory");
    __syncthreads();
    if (threadIdx.x == 0) {
        unsigned* bar = b.bar;
        __builtin_amdgcn_s_waitcnt(0);
        unsigned nloc = b.st[0], nx = b.st[1];
        if (nloc == 0u) { xcd_barrier_complete(bar, b.x, nloc, nx); b.st[0] = nloc; b.st[1] = nx; }
        const unsigned old = xb_add(&bar[XB_XSUB(b.x)], 1u);
        const unsigned gen = old / nloc;
        if (old + 1u == (gen + 1u) * nloc) {
            __builtin_amdgcn_fence(__ATOMIC_RELEASE, "agent");
            asm volatile("s_waitcnt vmcnt(0)" ::: "memory");
            const unsigned og = xb_add(&bar[XB_TOP], 1u);
            const unsigned tg = og / nx;
            if (og + 1u == (tg + 1u) * nx) xb_add(&bar[XB_TOPGEN], 1u);
            else XB_SPIN(xb_ld(&bar[XB_TOPGEN]) == tg, bar);
            __builtin_amdgcn_fence(__ATOMIC_ACQUIRE, "agent");
            xb_add(&bar[XB_XGEN(b.x)], 1u);
            asm volatile("s_waitcnt vmcnt(0)" ::: "memory");
        } else {
            XB_SPIN(xb_ld(&bar[XB_XGEN(b.x)]) == gen, bar);
            __builtin_amdgcn_fence(__ATOMIC_ACQUIRE, "agent");
            asm volatile("s_waitcnt vmcnt(0)" ::: "memory");
        }
    }
    __syncthreads();
}
constexpr int NWAVES = 8;
constexpr int RING_OFF = 0, RING_BYTES = 131072;
constexpr int LDSCTL_OFF = RING_BYTES, MISC_OFF = LDSCTL_OFF + 320;
constexpr int LDS_BYTES = 147456;
constexpr int CW_BAR = 4096;
constexpr size_t CTL_ZERO_BYTES = 64 * 1024;
static_assert((CW_BAR + XCD_BAR_WORDS) * 4 <= (int)CTL_ZERO_BYTES, "ctl");
#define LDS_WAIT() asm volatile("s_waitcnt lgkmcnt(0)" ::: "memory")

struct Args { P p; int ph_lo, ph_hi; };

template <class RowMap>
__device__ __forceinline__ void tr_item(const float* W, int K, int N, bf16* WT, LAS float* scr, int item, int lane, RowMap rm) {
    const int nblk = N / 32, kb = item / nblk, nb = item % nblk, k0 = 64 * kb, n0 = 32 * nb;
    float wv[32];
#pragma unroll
    for (int i = 0; i < 32; ++i) { const int kk = 2 * i + (lane >> 5); wv[i] = W[(size_t)(k0 + kk) * N + n0 + (lane & 31)]; }
#pragma unroll
    for (int i = 0; i < 32; ++i) { const int kk = 2 * i + (lane >> 5); scr[kk * 33 + (lane & 31)] = wv[i]; }
    LDS_WAIT(); asm volatile("" ::: "memory");
    const int c = lane & 7;
#pragma unroll
    for (int j = 0; j < 4; ++j) { const int n = (lane >> 3) + 8 * j; const LAS float* s = scr + (8 * c) * 33 + n;
        pg8::u32x4 o; o.x = pk2(s[0 * 33], s[1 * 33]); o.y = pk2(s[2 * 33], s[3 * 33]); o.z = pk2(s[4 * 33], s[5 * 33]); o.w = pk2(s[6 * 33], s[7 * 33]);
        *(pg8::u32x4*)(WT + (size_t)rm(n0 + n) * K + k0 + 8 * c) = o; }
    LDS_WAIT(); asm volatile("" ::: "memory");
}
struct RmId { __device__ __forceinline__ int operator()(int n) const { return n; } };
struct RmQK { __device__ __forceinline__ int operator()(int a) const { return a >= 1024 ? a : ((a & ~127) | (((a >> 4) & 3) << 5) | (((a >> 2) & 3) << 3) | (((a >> 6) & 1) << 2) | (a & 3)); } };
struct RmGU { int add; __device__ __forceinline__ int operator()(int f) const { return 256 * (f >> 7) + add + (f & 127); } };

__device__ __forceinline__ void ph_prologue(const P& p, LAS unsigned char* lds, int bid, int nblk) {
    const int tid = threadIdx.x, lane = tid & 63, wave = __builtin_amdgcn_readfirstlane(tid >> 6);
    const int gw = bid * NWAVES + wave, ngw = nblk * NWAVES, gt = bid * (NWAVES * 64) + tid, ngt = nblk * NWAVES * 64;
    unsigned char* ws = p.ws;
    LAS float* scr = (LAS float*)(lds + wave * 16384);
    bf16* WIN_T = (bf16*)(ws + WS_WIN_T); bf16* WOUT_T = (bf16*)(ws + WS_WOUT_T); bf16* WGU_T = (bf16*)(ws + WS_WGU_T); bf16* WDN_T = (bf16*)(ws + WS_WDN_T);
    constexpr int I_IN = 16 * 96, I_OUT = 16 * 32, I_E = 128, NITEMS = I_IN + I_OUT + NEXP * 3 * I_E;
    for (int it = gw; it < NITEMS; it += ngw) {
        int r = it;
        if (r < I_IN) { tr_item(p.w_in, D_, NIN, WIN_T, scr, r, lane, RmQK{}); continue; } r -= I_IN;
        if (r < I_OUT) { tr_item(p.w_out, D_, D_, WOUT_T, scr, r, lane, RmId{}); continue; } r -= I_OUT;
        const int e = r / (3 * I_E), q = r % (3 * I_E);
        if (q < I_E) tr_item(p.w_gu + (size_t)e * D_ * FF, D_, FF, WGU_T + (size_t)e * 512 * D_, scr, q, lane, RmGU{0});
        else if (q < 2 * I_E) tr_item(p.w_up + (size_t)e * D_ * FF, D_, FF, WGU_T + (size_t)e * 512 * D_, scr, q - I_E, lane, RmGU{128});
        else tr_item(p.w_dn + (size_t)e * FF * D_, FF, D_, WDN_T + (size_t)e * D_ * FF, scr, q - 2 * I_E, lane, RmId{});
    }
    ph_rmsnorm_bf16(p.x, p.g_mix, (bf16*)(ws + WS_H), gw, ngw, lane);
    { float* COS = (float*)(ws + WS_ROPE); float* SIN = COS + (size_t)T_ * 64;
      for (int i = gt; i < T_ * 64; i += ngt) { const int t = i >> 6, j = i & 63; float sn, cs; sincosf((float)p.pos[t] * inv_freq(j), &sn, &cs); COS[i] = cs; SIN[i] = sn; } }
    { bf16* WSM = (bf16*)(ws + WS_WSM);
      for (int i = gt; i < 4 * 128 * 128; i += ngt) { const int jj = i & 127, ii = (i >> 7) & 127; WSM[i] = jj <= ii ? f2bf(p.sgu_w[i]) : (bf16)0; }
      bf16* WRT = (bf16*)(ws + WS_WRT);
      for (int i = gt; i < 48 * 1024; i += ngt) { const int o = i >> 10, k = i & 1023;
          const float w = o < 32 ? p.w_re[((size_t)(o >> 3) * D_ + k) * 8 + (o & 7)] : (o < 36 ? p.w_rg[k * 4 + (o - 32)] : 0.f);
          const bf16 hi = f2bf(w); WRT[i] = hi; WRT[48 * 1024 + i] = f2bf(w - bf2f(hi)); } }
}

__global__ void __launch_bounds__(NWAVES * 64, 2) mk_fwd(Args args) {
    extern __shared__ __attribute__((aligned(16))) unsigned char lds_raw[];
    LAS unsigned char* lds = (LAS unsigned char*)lds_raw;
    volatile LAS unsigned* MISC = (volatile LAS unsigned*)(lds + MISC_OFF);
    const P& p = args.p;
    const int tid = threadIdx.x, lane = tid & 63, wave = __builtin_amdgcn_readfirstlane(tid >> 6);
    const int G = gridDim.x, bid = blockIdx.x;
    const int gw = bid * NWAVES + wave, ngw = G * NWAVES, gt = bid * (NWAVES * 64) + tid, ngt = G * NWAVES * 64;
    unsigned char* ws = p.ws;
    for (int u = tid; u < (LDS_BYTES - LDSCTL_OFF) / 4; u += NWAVES * 64) ((LAS unsigned*)(lds + LDSCTL_OFF))[u] = 0u;
    __syncthreads();
    const int lo = args.ph_lo, hi = args.ph_hi;
    XcdBarrier bar; bar.bar = (unsigned*)(ws + WS_CTL) + CW_BAR; bar.x = 0; bar.st = nullptr;
    if (hi - lo > 1) bar = xcd_barrier_post((unsigned*)(ws + WS_CTL) + CW_BAR, MISC + 8);
#ifndef DUP_PHASE
#define DUP_PHASE -1
#endif
#define IN(k) (lo <= (k) && (k) < hi)
#define PH(k) for (int rep_ = 0; rep_ < ((DUP_PHASE == (k)) ? 2 : 1); ++rep_)
#define SEAM(k) do { if (IN(k) && IN((k) + 1)) xcd_barrier(bar); } while (0)

    bf16* H = (bf16*)(ws + WS_H); bf16* PROJ = (bf16*)(ws + WS_PROJ); float* KVT = (float*)(ws + WS_KVT); bf16* ST = (bf16*)(ws + WS_ST); bf16* MIX = (bf16*)(ws + WS_MIX);
    float* SSQ = (float*)(ws + WS_SSQ); int4* ROUTE = (int4*)(ws + WS_ROUTE); int* CNT = (int*)(ws + WS_CNT); int* ETOK = (int*)(ws + WS_ETOK); float* EW = (float*)(ws + WS_EW);
    int2* TOKPOS = (int2*)(ws + WS_TOKPOS); int* TILE = (int*)(ws + WS_TILE); bf16* YE = (bf16*)(ws + WS_YE);

    if (IN(0)) PH(0) { ph_prologue(p, lds, bid, G); SEAM(0); }
    if (IN(1)) PH(1) {
        pg8::Gemm g{H, (const bf16*)(ws + WS_WIN_T), T_, NIN, D_}; pg8::StaticOrder S; S.init(T_, NIN, G, bid);
        pg8::EpiProj E{PROJ, (const float*)(ws + WS_ROPE), (const float*)(ws + WS_ROPE) + (size_t)T_ * 64};
        pg8::gemm_phase<pg8::EpiProj, pg8::StaticOrder, true, true>(lds + RING_OFF, g, S, E);
        SEAM(1);
    }
    if (IN(2)) PH(2) {
        tl::phase_kv(lds, PROJ, KVT, bid, G);
        tl::phase_sgu(lds, PROJ, (const bf16*)(ws + WS_WSM), p.sgu_b, p.sgu_gain, MIX, bid, G);
        SEAM(2);
    }
    if (IN(3)) PH(3) { ph_scan(KVT, ST, gt, ngt); SEAM(3); }
    if (IN(4)) PH(4) { tl::phase_ret(lds, PROJ, ST, p.gn_gain, MIX, bid, G); SEAM(4); }
    if (IN(5)) PH(5) {
        pg8::Gemm g{MIX, (const bf16*)(ws + WS_WOUT_T), T_, D_, D_}; pg8::StaticOrder S; S.init(T_, D_, G, bid);
        pg8::EpiRes E{p.x, p.out, SSQ};
        pg8::gemm_phase<pg8::EpiRes, pg8::StaticOrder, true, true>(lds + RING_OFF, g, S, E);
        SEAM(5);
    }
    if (IN(6)) PH(6) { rt::ph_router(lds, p.out, SSQ, p.g_ffn, (const bf16*)(ws + WS_WRT), p.b_rg, p.b_re, H, ROUTE, CNT, bid, G); SEAM(6); }
    if (IN(7)) PH(7) { __syncthreads(); ph_lists(ROUTE, CNT, ETOK, EW, TOKPOS, TILE, (int*)lds_raw, bid, G); SEAM(7); }
    if (IN(8)) PH(8) {
        pg8::MoeASched S{TILE, ETOK, (const char*)H, (const char*)(ws + WS_WGU_T), G, bid}; pg8::EpiAct E{(bf16*)(ws + WS_ACT), EW};
        pg8::gemm_phase_g<pg8::EpiAct, pg8::MoeASched>(lds + RING_OFF, D_, S, E);
        SEAM(8);
    }
    if (IN(9)) PH(9) {
        pg8::MoeBSched S{TILE, (const char*)(ws + WS_ACT), (const char*)(ws + WS_WDN_T), G, bid}; pg8::EpiYE E{YE};
        pg8::gemm_phase_g<pg8::EpiYE, pg8::MoeBSched>(lds + RING_OFF, FF, S, E);
        SEAM(9);
    }
    if (IN(10)) { ph_final(p.out, YE, TOKPOS, p.g_fin, gw, ngw, lane); }
#undef IN
#undef PH
#undef SEAM
}

extern "C" void kernel_launch(void* const* d_in, const int* in_sizes, int n_in, void* d_out, int out_size, void* d_ws, size_t ws_size, hipStream_t stream) {
    static int grid = 0;
    if (grid == 0) {
        if (n_in != 18 || ws_size < WS_END) fprintf(stderr, "kernel_launch: unexpected n_in %d / ws_size %zu\n", n_in, ws_size);
        (void)hipFuncSetAttribute((const void*)mk_fwd, hipFuncAttributeMaxDynamicSharedMemorySize, LDS_BYTES);
        int dev = 0, cus = 0, per_cu = 0;
        (void)hipGetDevice(&dev); (void)hipDeviceGetAttribute(&cus, hipDeviceAttributeMultiprocessorCount, dev);
        (void)hipOccupancyMaxActiveBlocksPerMultiprocessor(&per_cu, (const void*)mk_fwd, NWAVES * 64, LDS_BYTES);
        if (per_cu < 1) fprintf(stderr, "kernel_launch: occupancy query says %d blocks per CU\n", per_cu);
        (void)hipGetLastError();
        grid = cus > 0 ? cus : 256;
    }
    P p{};
    p.x = (const float*)d_in[0]; p.pos = (const int*)d_in[1]; p.g_mix = (const float*)d_in[2]; p.w_in = (const float*)d_in[3]; p.gn_gain = (const float*)d_in[4];
    p.sgu_gain = (const float*)d_in[5]; p.sgu_w = (const float*)d_in[6]; p.sgu_b = (const float*)d_in[7]; p.w_out = (const float*)d_in[8]; p.g_ffn = (const float*)d_in[9];
    p.w_rg = (const float*)d_in[10]; p.b_rg = (const float*)d_in[11]; p.w_re = (const float*)d_in[12]; p.b_re = (const float*)d_in[13];
    p.w_gu = (const float*)d_in[14]; p.w_up = (const float*)d_in[15]; p.w_dn = (const float*)d_in[16]; p.g_fin = (const float*)d_in[17];
    p.out = (float*)d_out; p.ws = (unsigned char*)d_ws;
    unsigned char* ws = p.ws;
    bf16* PROJ = (bf16*)(ws + WS_PROJ); float* KVT = (float*)(ws + WS_KVT); bf16* ST = (bf16*)(ws + WS_ST); bf16* MIX = (bf16*)(ws + WS_MIX);
    float* SSQ = (float*)(ws + WS_SSQ); int4* ROUTE = (int4*)(ws + WS_ROUTE); int* CNT = (int*)(ws + WS_CNT); int* ETOK = (int*)(ws + WS_ETOK); float* EW = (float*)(ws + WS_EW);
    int* TILE = (int*)(ws + WS_TILE); float* TMP = (float*)(ws + WS_TMP); bf16* ACT = (bf16*)(ws + WS_ACT); bf16* YE = (bf16*)(ws + WS_YE);
    bf16* H2 = (bf16*)(ws + WS_H);
    (void)ST; (void)SSQ;
    (void)hipMemsetAsync(ws + WS_CTL, 0, CTL_ZERO_BYTES, stream);
#define MK(lo, hi) do { Args a{}; a.p = p; a.ph_lo = (lo); a.ph_hi = (hi); hipLaunchKernelGGL(mk_fwd, dim3(grid), dim3(NWAVES * 64), LDS_BYTES, stream, a); } while (0)
    MK(0, 11);
    (void)PROJ; (void)KVT; (void)MIX; (void)H2; (void)ROUTE; (void)CNT; (void)TMP; (void)ACT; (void)YE; (void)ETOK; (void)EW; (void)TILE;
#undef MK
}
```

```cpp
#include <hip/hip_runtime.h>
#include <cstdio>
#include <cstdint>

namespace {
constexpr int B_ = 2, S_ = 8192, T_ = B_ * S_, D_ = 1024;
constexpr int RH = 4, DH = 128, CH = 128, NCH = S_ / CH;
constexpr int NIN = 3072;
constexpr int C_Q = 0, C_K = 512, C_V = 1024, C_G = 1536, C_U = 2048, C_VS = 2560;
constexpr int NEXP = 32, FF = 256;
constexpr int MAXENT = 2 * T_ + NEXP * 256;
constexpr int MAXTILES = MAXENT / 256;
constexpr float EPS = 1e-6f;

typedef unsigned short bf16;
typedef float f32x4 __attribute__((ext_vector_type(4)));

constexpr size_t MiB = 1u << 20;
constexpr size_t WS_CTL = 0;
constexpr size_t WS_WIN_T = 1 * MiB, WS_WOUT_T = 7 * MiB, WS_WGU_T = 9 * MiB, WS_WDN_T = 41 * MiB;
constexpr size_t WS_ROUTE = 57 * MiB;
constexpr size_t WS_CNT = 57 * MiB + 256 * 1024;
constexpr size_t WS_ETOK = 57 * MiB + 512 * 1024;
constexpr size_t WS_EW = 57 * MiB + 768 * 1024;
constexpr size_t WS_TOKPOS = 58 * MiB;
constexpr size_t WS_TILE = 58 * MiB + 256 * 1024;
constexpr size_t WS_SSQ = 59 * MiB;
constexpr size_t WS_WSM = 60 * MiB;
constexpr size_t WS_WRT = 60 * MiB + 512 * 1024;
constexpr size_t WS_H = 64 * MiB;
constexpr size_t WS_ST = 64 * MiB;
constexpr size_t WS_PROJ = 96 * MiB;
constexpr size_t WS_YE = 96 * MiB;
constexpr size_t WS_TMP = 96 * MiB;
constexpr size_t WS_MIX = 192 * MiB;
constexpr size_t WS_ACT = 192 * MiB;
constexpr size_t WS_KVT = 224 * MiB;
constexpr size_t WS_ROPE = 224 * MiB;
constexpr size_t WS_END = 256 * MiB;

struct P {
    const float* x; const int* pos; const float *g_mix, *w_in, *gn_gain, *sgu_gain, *sgu_w, *sgu_b, *w_out, *g_ffn, *w_rg, *b_rg, *w_re, *b_re, *w_gu, *w_up, *w_dn, *g_fin;
    float* out; unsigned char* ws;
};

__device__ __forceinline__ float bf2f(bf16 b) { return __uint_as_float(((unsigned)b) << 16); }
__device__ __forceinline__ bf16 f2bf(float f) { unsigned u = __float_as_uint(f); u += 0x7fffu + ((u >> 16) & 1u); return (bf16)(u >> 16); }
__device__ __forceinline__ unsigned pk2(float lo, float hi) { return (unsigned)f2bf(lo) | ((unsigned)f2bf(hi) << 16); }
__device__ __forceinline__ float wave_sum(float v) {
#pragma unroll
    for (int o = 32; o >= 1; o >>= 1) v += __shfl_xor(v, o);
    return v;
}
__device__ __forceinline__ float silu_f(float v) { return v / (1.0f + __expf(-v)); }
__device__ __forceinline__ float gelu_f(float v) { return 0.5f * v * (1.0f + erff(v * 0.70710678118654752f)); }
__device__ __forceinline__ float log2_gamma(int h) { return log2f(1.0f - exp2f(-5.0f - (float)h)); }
__device__ __forceinline__ float inv_freq(int j) { return powf(10000.0f, -(float)j * (2.0f / 128.0f)); }

__device__ __forceinline__ void ph_rmsnorm_bf16(const float* X, const float* gain, bf16* H, int gw, int ngw, int lane) {
    for (int m = gw; m < T_; m += ngw) {
        const f32x4* xr = (const f32x4*)(X + (size_t)m * D_) + lane;
        f32x4 v[4]; float s = 0.f;
#pragma unroll
        for (int j = 0; j < 4; ++j) { v[j] = xr[64 * j]; s += (v[j].x * v[j].x + v[j].y * v[j].y) + (v[j].z * v[j].z + v[j].w * v[j].w); }
        const float rstd = 1.0f / sqrtf(wave_sum(s) * (1.0f / D_) + EPS);
        unsigned long long* o8 = (unsigned long long*)(H + (size_t)m * D_) + lane;
#pragma unroll
        for (int j = 0; j < 4; ++j) { const f32x4 g = ((const f32x4*)gain)[lane + 64 * j];
            o8[64 * j] = (unsigned long long)pk2(v[j].x * rstd * g.x, v[j].y * rstd * g.y) | ((unsigned long long)pk2(v[j].z * rstd * g.z, v[j].w * rstd * g.w) << 32); }
    }
}

__device__ __forceinline__ void ph_scan(const bf16* KVT, bf16* ST, int gtid, int ngt) {
    for (int item = gtid; item < B_ * RH * 128 * 32; item += ngt) {
        const int d4 = item & 31, e = (item >> 5) & 127, h = (item >> 12) & 3, b = item >> 14;
        const float G = exp2f(128.0f * log2_gamma(h));
        f32x4 s = (f32x4){0.f, 0.f, 0.f, 0.f};
        const size_t nstride = (size_t)RH * 16384;
        const size_t base = ((size_t)(b * NCH) * RH + h) * 16384 + (size_t)e * 128 + d4 * 4;
        for (int n0 = 0; n0 < NCH; n0 += 16) {
            unsigned long long kv[16];
#pragma unroll
            for (int i = 0; i < 16; ++i) kv[i] = *(const unsigned long long*)(KVT + base + (size_t)(n0 + i) * nstride);
#pragma unroll
            for (int i = 0; i < 16; ++i) {
                *(unsigned long long*)(ST + base + (size_t)(n0 + i) * nstride) = (unsigned long long)pk2(s.x, s.y) | ((unsigned long long)pk2(s.z, s.w) << 32);
                const unsigned lo = (unsigned)kv[i], hi = (unsigned)(kv[i] >> 32);
                s = s * G + (f32x4){__uint_as_float(lo << 16), __uint_as_float(lo & 0xffff0000u), __uint_as_float(hi << 16), __uint_as_float(hi & 0xffff0000u)};
            }
        }
    }
}

__device__ __forceinline__ void route_decide(const float (&lg)[4], const float (&le)[4][8], int& e1, int& e2, float& w1, float& w2) {
    int gs = 0; float gm = lg[0];
#pragma unroll
    for (int g = 1; g < 4; ++g) if (lg[g] > gm) { gm = lg[g]; gs = g; }
    float den = 0.f;
#pragma unroll
    for (int g = 0; g < 4; ++g) den += __expf(lg[g] - gm);
    const float gweight = 1.0f / den;
    float sel[8];
#pragma unroll
    for (int e = 0; e < 8; ++e) { sel[e] = le[0][e];
#pragma unroll
        for (int g = 1; g < 4; ++g) sel[e] = (gs == g) ? le[g][e] : sel[e]; }
    int i1 = 0; float v1 = sel[0];
#pragma unroll
    for (int e = 1; e < 8; ++e) if (sel[e] > v1) { v1 = sel[e]; i1 = e; }
    int i2 = (i1 == 0) ? 1 : 0; float v2 = (i1 == 0) ? sel[1] : sel[0];
#pragma unroll
    for (int e = 1; e < 8; ++e) if (e != i1 && sel[e] > v2) { v2 = sel[e]; i2 = e; }
    const float ex = __expf(v2 - v1);
    const float a = 1.0f / (1.0f + ex);
    e1 = gs * 8 + i1; e2 = gs * 8 + i2; w1 = gweight * a; w2 = gweight * ex * a;
}

__device__ __forceinline__ void ph_rank(int4* ROUTE, int* CNT, int gw, int ngw, int lane) {
    for (int c = gw; c < T_ / 64; c += ngw) {
        int4 r = ROUTE[c * 64 + lane];
        const int e1 = r.x & 255, e2 = r.y & 255;
        int r1 = 0, r2 = 0, mycnt = 0;
        const unsigned long long lt = (1ull << lane) - 1ull;
        for (int e = 0; e < NEXP; ++e) {
            const unsigned long long m = __ballot(e1 == e || e2 == e);
            const int below = __popcll(m & lt);
            if (e1 == e) r1 = below;
            if (e2 == e) r2 = below;
            if (lane == e) mycnt = __popcll(m);
        }
        r.x = e1 | (r1 << 8); r.y = e2 | (r2 << 8);
        ROUTE[c * 64 + lane] = r;
        if (lane < NEXP) CNT[c * NEXP + lane] = mycnt;
    }
}

__device__ __forceinline__ void ph_lists(const int4* ROUTE, const int* CNT, int* ETOK, float* EW, int2* TOKPOS, int* TILE, int* lds, int bid, int nblk) {
    const int tid = threadIdx.x;
    int* psum = lds;
    int* tot = lds + 512;
    int* off = lds + 544;
    int* base = lds + 576;
    { const int e = tid & 31, part = tid >> 5; int s = 0;
      for (int i = 0; i < 16; ++i) s += CNT[(part * 16 + i) * NEXP + e];
      psum[part * 32 + e] = s; }
    __syncthreads();
    if (tid < 32) { int s = 0; for (int p = 0; p < 16; ++p) s += psum[p * 32 + tid]; tot[tid] = s; }
    __syncthreads();
    if (tid == 0) { int o = 0; for (int e = 0; e < NEXP; ++e) { off[e] = o; o += ((tot[e] + 255) >> 8) << 8; } lds[608] = o >> 8; }
    __syncthreads();
    const int ntiles = lds[608];
    if (bid == 0) {
        if (tid == 0) TILE[0] = ntiles;
        if (tid < NEXP) { const int t0 = off[tid] >> 8, nt = (tot[tid] + 255) >> 8; for (int i = 0; i < nt; ++i) TILE[1 + t0 + i] = tid; }
    }
    for (int e = bid; e < NEXP; e += nblk) {
        const int lo = off[e] + tot[e], hi = off[e] + (((tot[e] + 255) >> 8) << 8);
        for (int p = lo + tid; p < hi; p += blockDim.x) { ETOK[p] = 0; EW[p] = 0.f; }
    }
    for (int c = bid; c < T_ / 64; c += nblk) {
        __syncthreads();
        if (tid < 32) { int s = off[tid]; const int part = c >> 4;
            for (int p = 0; p < part; ++p) s += psum[p * 32 + tid];
            for (int ch = part * 16; ch < c; ++ch) s += CNT[ch * NEXP + tid];
            base[tid] = s; }
        __syncthreads();
        if (tid < 64) { const int t = c * 64 + tid; const int4 r = ROUTE[t];
            const int p1 = base[r.x & 255] + (r.x >> 8), p2 = base[r.y & 255] + (r.y >> 8);
            ETOK[p1] = t; EW[p1] = __int_as_float(r.z); ETOK[p2] = t; EW[p2] = __int_as_float(r.w);
            TOKPOS[t] = make_int2(p1, p2); }
    }
}

__device__ __forceinline__ void ph_final(float* out, const bf16* YE, const int2* TOKPOS, const float* gain, int gw, int ngw, int lane) {
    for (int m = gw; m < T_; m += ngw) {
        const int2 pp = TOKPOS[m];
        f32x4* xr = (f32x4*)(out + (size_t)m * D_) + lane;
        const unsigned long long* y1 = (const unsigned long long*)(YE + (size_t)pp.x * D_) + lane;
        const unsigned long long* y2 = (const unsigned long long*)(YE + (size_t)pp.y * D_) + lane;
        f32x4 v[4]; float s = 0.f;
#pragma unroll
        for (int j = 0; j < 4; ++j) {
            v[j] = xr[64 * j]; const unsigned long long a = y1[64 * j], b = y2[64 * j];
            v[j].x += bf2f((bf16)(a & 0xffff)) + bf2f((bf16)(b & 0xffff));
            v[j].y += bf2f((bf16)((a >> 16) & 0xffff)) + bf2f((bf16)((b >> 16) & 0xffff));
            v[j].z += bf2f((bf16)((a >> 32) & 0xffff)) + bf2f((bf16)((b >> 32) & 0xffff));
            v[j].w += bf2f((bf16)(a >> 48)) + bf2f((bf16)(b >> 48));
            s += (v[j].x * v[j].x + v[j].y * v[j].y) + (v[j].z * v[j].z + v[j].w * v[j].w);
        }
        const float rstd = 1.0f / sqrtf(wave_sum(s) * (1.0f / D_) + EPS);
#pragma unroll
        for (int j = 0; j < 4; ++j) { const f32x4 g = ((const f32x4*)gain)[lane + 64 * j]; xr[64 * j] = v[j] * rstd * g; }
    }
}

}
#define LAS __attribute__((address_space(3)))
namespace pg8 {
#define PG8_LAS __attribute__((address_space(3)))
typedef unsigned short bf16_t;
typedef short bf16x8 __attribute__((ext_vector_type(8)));
typedef float f32x4 __attribute__((ext_vector_type(4)));
typedef unsigned u32x4 __attribute__((ext_vector_type(4)));
constexpr int BM = 256, BK = 64, HALF = 128, HTB = HALF * BK * 2  , STAGE_BYTES = 8 * HTB, NXCD = 8, WGM = 8;

__host__ __device__ __forceinline__ int lds_byte(int r, int c) { const int st = (r >> 4) * 2 + (c >> 5), rr = r & 15, cc = c & 31, ob = rr * 64 + cc * 2; return st * 1024 + (ob ^ (((ob >> 9) & 1) << 5)); }
__host__ __device__ __forceinline__ void stage_rc(int b, int& R, int& C) { const int st = b / 1024, sb = b % 1024, swz = sb ^ (((sb >> 9) & 1) << 5); R = (st >> 1) * 16 + swz / 64; C = (st & 1) * 32 + (swz % 64) / 2; }
__host__ __device__ __forceinline__ int perm32(int rho) { const int n = rho >> 4, i = rho & 15; return 8 * (i >> 2) + 4 * n + (i & 3); }

struct Unit { int pm, pn; };
struct Gemm { const bf16_t* A; const bf16_t* Bt; int M, N, K; };

struct StaticOrder {
    int nM, nN, nwg, G, c;
    __host__ __device__ void init(int M, int N, int G_, int c_) { nM = M / BM; nN = N / BM; nwg = nM * nN; G = G_; c = c_; }
    __host__ __device__ bool next(int i, Unit& u) const {
        const long L = (long)i * G + c; if (L >= nwg) return false;
        int wgid = (int)L; { const int q = nwg / NXCD, r = nwg % NXCD, xcd = wgid % NXCD, off = wgid / NXCD; wgid = (xcd < r ? xcd * (q + 1) : r * (q + 1) + (xcd - r) * q) + off; }
        const int nig = WGM * nN, gid = wgid / nig, fm = gid * WGM, gsz = (nM - fm) < WGM ? (nM - fm) : WGM;
        u.pm = fm + ((wgid % nig) % gsz); u.pn = (wgid % nig) / gsz; return true;
    }
    __device__ __forceinline__ void a_ready(const Unit&) const {}
    __device__ __forceinline__ void done(const Unit&) const {}
};
typedef float cvt_f32x2 __attribute__((ext_vector_type(2))); typedef __bf16 cvt_bf16x2 __attribute__((ext_vector_type(2)));
__device__ __forceinline__ unsigned cvt_pk_bf16(float lo, float hi) { const cvt_f32x2 v = {lo, hi}; return __builtin_bit_cast(unsigned, __builtin_convertvector(v, cvt_bf16x2)); }
typedef float f32x2 __attribute__((ext_vector_type(2)));
__device__ __forceinline__ f32x2 gelu_pk(f32x2 v) {
    const f32x2 av = __builtin_elementwise_abs(v), d = av * 0.2316418882f + 1.0f;
    f32x2 t; t.x = __builtin_amdgcn_rcpf(d.x); t.y = __builtin_amdgcn_rcpf(d.y);
    f32x2 q = t * 0.5307027145f + (-0.7265760135f); q = q * t + 0.7107068705f; q = q * t + (-0.142248368f); q = q * t + 0.127414796f; q = q * t;
    const f32x2 s = (v * v) * (-0.72134752044f);
    f32x2 e; e.x = __builtin_amdgcn_exp2f(s.x); e.y = __builtin_amdgcn_exp2f(s.y);
    const f32x2 m = v * (q * e), r = v - m;
    f32x2 o; o.x = v.x < 0.f ? m.x : r.x; o.y = v.y < 0.f ? m.y : r.y; return o;
}
template <class Epi, class Sched, bool ALIGN_EPI = false, bool SP2 = false>
__device__ __forceinline__ void gemm_phase(PG8_LAS unsigned char* lds, const Gemm g, const Sched& S, const Epi& E) {
    const int tid = threadIdx.x, wid = __builtin_amdgcn_readfirstlane(tid >> 6), lane = tid & 63, wr = wid >> 2, wc = wid & 3, fr = lane & 15, fq = lane >> 4;
    const int K = g.K, nt = K / BK;
    unsigned voffA[2], voffB[2];
#pragma unroll
    for (int i = 0; i < 2; ++i) { int R, C; stage_rc(tid * 16 + i * 8192, R, C); const int Rb = Epi::PERM ? ((R & ~31) + perm32(R & 31)) : R;
        voffA[i] = (unsigned)(R * K + C) * 2u; voffB[i] = (unsigned)(Rb * K + C) * 2u; }
    const size_t kstep = (size_t)(BK * 2);
    const size_t hstep = (size_t)HALF * K * 2;
    const size_t tstep = 2 * hstep;
    const unsigned ldsw = (unsigned)wid * 1024u;
    const int aoff = lds_byte(wr * 64 + fr, fq * 8), boff = lds_byte(wc * 32 + fr, fq * 8);
#define PG8_SA(b, h) (((b) * 2 + (h)) * HTB)
#define PG8_SB(b, h) ((4 + (b) * 2 + (h)) * HTB)
#define PG8_STAGE(bufoff, gbase, voff) do { _Pragma("unroll") for (int _i = 0; _i < 2; ++_i) \
        __builtin_amdgcn_global_load_lds((const unsigned*)((const char*)(gbase) + (voff)[_i]), (PG8_LAS unsigned*)(lds + (bufoff) + ldsw + _i * 8192), 16, 0, 0); } while (0)
#define PG8_LDA(dst, b, h) do { _Pragma("unroll") for (int m = 0; m < 4; ++m) _Pragma("unroll") for (int k = 0; k < 2; ++k) dst[m][k] = *(const PG8_LAS bf16x8*)(lds + PG8_SA(b, h) + aoff + m * 2048 + k * 1024); } while (0)
#define PG8_LDB(dst, b, h) do { _Pragma("unroll") for (int n = 0; n < 2; ++n) _Pragma("unroll") for (int k = 0; k < 2; ++k) dst[n][k] = *(const PG8_LAS bf16x8*)(lds + PG8_SB(b, h) + boff + n * 2048 + k * 1024); } while (0)
#define PG8_MMA(ai, bj, At, Bt) do { __builtin_amdgcn_s_setprio(1); _Pragma("unroll") for (int m = 0; m < 4; ++m) _Pragma("unroll") for (int n = 0; n < 2; ++n) _Pragma("unroll") for (int k = 0; k < 2; ++k) \
        acc[ai][bj][m][n] = __builtin_amdgcn_mfma_f32_16x16x32_bf16(Bt[n][k], At[m][k], acc[ai][bj][m][n], 0, 0, 0); __builtin_amdgcn_s_setprio(0); } while (0)
#define PG8_WAIT_V(n) asm volatile("s_waitcnt vmcnt(" #n ")" ::: "memory")
#define PG8_WAIT_L(n) asm volatile("s_waitcnt lgkmcnt(" #n ")" ::: "memory")
#define PG8_BAR __builtin_amdgcn_s_barrier()
#define PG8_SCHED __builtin_amdgcn_sched_barrier(0)
    Unit cur, nxt; int ui = 0;
    if (!S.next(0, cur)) return;
    f32x4 acc[2][2][4][2];
#pragma unroll
    for (int a = 0; a < 2; ++a)
#pragma unroll
        for (int b = 0; b < 2; ++b)
#pragma unroll
            for (int m = 0; m < 4; ++m)
#pragma unroll
                for (int n = 0; n < 2; ++n) acc[a][b][m][n] = (f32x4){0.f, 0.f, 0.f, 0.f};
    bf16x8 At[4][2], B0[2][2], B1[2][2];
    const char* cA = (const char*)g.A + (size_t)cur.pm * tstep; const char* cB = (const char*)g.Bt + (size_t)cur.pn * tstep;
    S.a_ready(cur);
    if constexpr (SP2) {
        PG8_STAGE(PG8_SB(0, 0), cB, voffB); PG8_STAGE(PG8_SB(0, 1), cB + hstep, voffB); PG8_STAGE(PG8_SA(0, 0), cA, voffA); PG8_STAGE(PG8_SA(0, 1), cA + hstep, voffA);
        if (wr == 1) PG8_BAR;
        PG8_WAIT_V(2); PG8_BAR;
        PG8_STAGE(PG8_SB(1, 0), cB + kstep, voffB); PG8_STAGE(PG8_SA(1, 0), cA + kstep, voffA); PG8_STAGE(PG8_SB(1, 1), cB + hstep + kstep, voffB);
        PG8_WAIT_V(6); PG8_BAR;
    } else {
        PG8_STAGE(PG8_SB(0, 0), cB, voffB); PG8_STAGE(PG8_SA(0, 0), cA, voffA); PG8_STAGE(PG8_SB(0, 1), cB + hstep, voffB); PG8_STAGE(PG8_SA(0, 1), cA + hstep, voffA);
        if (wr == 1) PG8_BAR;
        PG8_WAIT_V(4); PG8_BAR;
        PG8_STAGE(PG8_SB(1, 0), cB + kstep, voffB); PG8_STAGE(PG8_SA(1, 0), cA + kstep, voffA); PG8_STAGE(PG8_SB(1, 1), cB + hstep + kstep, voffB);
        PG8_WAIT_V(6); PG8_BAR;
    }
    for (;;) {
        const bool has_next = S.next(ui + 1, nxt);
        const char* nA = has_next ? (const char*)g.A + (size_t)nxt.pm * tstep : cA; const char* nB = has_next ? (const char*)g.Bt + (size_t)nxt.pn * tstep : cB;
        for (int t = 0; t < nt; t += 2) {
            const bool last = (t == nt - 2);
            const char* a1 = cA + (size_t)(t + 1) * kstep;
            const char* a2 = last ? nA : cA + (size_t)(t + 2) * kstep; const char* b2 = last ? nB : cB + (size_t)(t + 2) * kstep;
            const char* a3 = a2 + kstep; const char* b3 = b2 + kstep;
            if (last && has_next) S.a_ready(nxt);
            if constexpr (SP2) {
            PG8_LDB(B0, 0, 0); PG8_LDB(B1, 0, 1); PG8_SCHED; PG8_LDA(At, 0, 0); PG8_STAGE(PG8_SA(1, 1), a1 + hstep, voffA);
            PG8_WAIT_V(8); PG8_WAIT_L(0); PG8_BAR; PG8_MMA(0, 0, At, B0); PG8_MMA(0, 1, At, B1); PG8_BAR; PG8_SCHED;
            PG8_LDA(At, 0, 1); PG8_STAGE(PG8_SB(0, 0), b2, voffB); PG8_STAGE(PG8_SB(0, 1), b2 + hstep, voffB); PG8_STAGE(PG8_SA(0, 0), a2, voffA);
            PG8_WAIT_V(8); PG8_WAIT_L(0); PG8_BAR; PG8_MMA(1, 0, At, B0); PG8_MMA(1, 1, At, B1); PG8_BAR; PG8_SCHED;
            PG8_LDB(B0, 1, 0); PG8_LDB(B1, 1, 1); PG8_SCHED; PG8_LDA(At, 1, 0); PG8_STAGE(PG8_SA(0, 1), a2 + hstep, voffA);
            PG8_WAIT_V(8); PG8_WAIT_L(0); PG8_BAR; PG8_MMA(0, 0, At, B0); PG8_MMA(0, 1, At, B1); PG8_BAR; PG8_SCHED;
            PG8_LDA(At, 1, 1); PG8_STAGE(PG8_SB(1, 0), b3, voffB); PG8_STAGE(PG8_SB(1, 1), b3 + hstep, voffB); PG8_STAGE(PG8_SA(1, 0), a3, voffA);
            PG8_WAIT_V(8); PG8_WAIT_L(0); PG8_BAR; PG8_MMA(1, 0, At, B0); PG8_MMA(1, 1, At, B1); PG8_BAR; PG8_SCHED;
            } else {
            PG8_LDB(B0, 0, 0); PG8_SCHED; PG8_LDA(At, 0, 0); PG8_STAGE(PG8_SA(1, 1), a1 + hstep, voffA);
            PG8_WAIT_L(8); PG8_BAR; PG8_WAIT_L(0); PG8_MMA(0, 0, At, B0); PG8_BAR; PG8_SCHED;
            PG8_LDB(B1, 0, 1); PG8_STAGE(PG8_SB(0, 0), b2, voffB);
            PG8_BAR; PG8_WAIT_L(0); PG8_MMA(0, 1, At, B1); PG8_BAR;
            PG8_LDA(At, 0, 1); PG8_STAGE(PG8_SA(0, 0), a2, voffA);
            PG8_BAR; PG8_WAIT_L(0); PG8_MMA(1, 0, At, B0); PG8_BAR; PG8_SCHED;
            PG8_STAGE(PG8_SB(0, 1), b2 + hstep, voffB);
            PG8_WAIT_V(6); PG8_BAR; PG8_MMA(1, 1, At, B1); PG8_BAR;
            PG8_LDB(B0, 1, 0); PG8_SCHED; PG8_LDA(At, 1, 0); PG8_STAGE(PG8_SA(0, 1), a2 + hstep, voffA);
            PG8_WAIT_L(8); PG8_BAR; PG8_WAIT_L(0); PG8_MMA(0, 0, At, B0); PG8_BAR; PG8_SCHED;
            PG8_LDB(B1, 1, 1); PG8_STAGE(PG8_SB(1, 0), b3, voffB);
            PG8_BAR; PG8_WAIT_L(0); PG8_MMA(0, 1, At, B1); PG8_BAR;
            PG8_LDA(At, 1, 1); PG8_STAGE(PG8_SA(1, 0), a3, voffA);
            PG8_BAR; PG8_WAIT_L(0); PG8_MMA(1, 0, At, B0); PG8_BAR; PG8_SCHED;
            PG8_STAGE(PG8_SB(1, 1), b3 + hstep, voffB);
            PG8_WAIT_V(6); PG8_BAR; PG8_MMA(1, 1, At, B1); PG8_BAR;
            }
        }
        if constexpr (ALIGN_EPI) { if (wr == 0) PG8_BAR; }
        if constexpr (!Epi::AFTER_DRAIN) { E(acc, cur, wr, wc, fr, fq); S.done(cur); }
        if (!has_next) break;
#pragma unroll
        for (int a = 0; a < 2; ++a)
#pragma unroll
            for (int b = 0; b < 2; ++b)
#pragma unroll
                for (int m = 0; m < 4; ++m)
#pragma unroll
                    for (int n = 0; n < 2; ++n) acc[a][b][m][n] = (f32x4){0.f, 0.f, 0.f, 0.f};
        cur = nxt; cA = nA; cB = nB; ++ui;
        if constexpr (ALIGN_EPI) { if (wr == 1) PG8_BAR; }
    }
    PG8_WAIT_V(0);
    if constexpr (!ALIGN_EPI) { if (wr == 0) PG8_BAR; }
    PG8_BAR;
    if constexpr (Epi::AFTER_DRAIN) { E.fused(acc, cur, wr, wc, fr, fq, lds, wid, lane); S.done(cur); }
#undef PG8_SA
#undef PG8_SB
#undef PG8_STAGE
#undef PG8_LDA
#undef PG8_LDB
#undef PG8_MMA
#undef PG8_WAIT_V
#undef PG8_WAIT_L
#undef PG8_BAR
#undef PG8_SCHED
}
}
namespace pg8 {
typedef unsigned u32x2 __attribute__((ext_vector_type(2)));
__device__ __forceinline__ f32x4 silu4(f32x4 v) {
    f32x4 o;
#pragma unroll
    for (int j = 0; j < 4; ++j) o[j] = v[j] * __builtin_amdgcn_rcpf(1.0f + __builtin_amdgcn_exp2f(-1.44269504089f * v[j]));
    return o;
}
struct EpiProj {
    static constexpr bool PERM = true, AFTER_DRAIN = false;
    bf16_t* O; const float* COS; const float* SIN;
    __device__ __forceinline__ void operator()(const f32x4 (&acc)[2][2][4][2], const Unit& u, int wr, int wc, int fr, int fq) const {
        const int row0 = u.pm * BM + wr * 64 + fr; const int seg = u.pn >> 1;
        if (seg <= 1) {
            const float sc = seg == 1 ? 0.08838834764831845f : 1.0f;
#pragma unroll
            for (int ai = 0; ai < 2; ++ai)
#pragma unroll
                for (int m = 0; m < 4; ++m) { const int r = row0 + ai * HALF + m * 16;
                    const f32x4 cs = *(const f32x4*)(COS + (size_t)r * 64 + 16 * wc + 4 * fq) * sc, sn = *(const f32x4*)(SIN + (size_t)r * 64 + 16 * wc + 4 * fq) * sc;
                    bf16_t* rowp = O + ((size_t)(seg * 4 + 2 * (u.pn & 1)) * 16384 + r) * 128 + 16 * wc + 4 * fq;
#pragma unroll
                    for (int bj = 0; bj < 2; ++bj) { const f32x4 x1 = acc[ai][bj][m][0], x2 = acc[ai][bj][m][1];
                        const f32x4 y1 = x1 * cs - x2 * sn, y2 = x1 * sn + x2 * cs;
                        u32x2 w1, w2; w1.x = cvt_pk_bf16(y1[0], y1[1]); w1.y = cvt_pk_bf16(y1[2], y1[3]); w2.x = cvt_pk_bf16(y2[0], y2[1]); w2.y = cvt_pk_bf16(y2[2], y2[3]);
                        *(u32x2*)(rowp + (size_t)bj * 16384 * 128) = w1; *(u32x2*)(rowp + (size_t)bj * 16384 * 128 + 64) = w2; } }
        } else {
#pragma unroll
            for (int ai = 0; ai < 2; ++ai)
#pragma unroll
                for (int m = 0; m < 4; ++m) { bf16_t* rowp = O + ((size_t)(seg * 4 + 2 * (u.pn & 1)) * 16384 + row0 + ai * HALF + m * 16) * 128 + wc * 32 + 8 * fq;
#pragma unroll
                    for (int bj = 0; bj < 2; ++bj) { f32x4 v0 = acc[ai][bj][m][0], v1 = acc[ai][bj][m][1];
                        if (seg == 3) { v0 = silu4(v0); v1 = silu4(v1); }
                        if (seg >= 4) { f32x2 a = gelu_pk((f32x2){v0[0], v0[1]}), b = gelu_pk((f32x2){v0[2], v0[3]}), c = gelu_pk((f32x2){v1[0], v1[1]}), d = gelu_pk((f32x2){v1[2], v1[3]});
                            v0 = (f32x4){a.x, a.y, b.x, b.y}; v1 = (f32x4){c.x, c.y, d.x, d.y}; }
                        u32x4 w; w.x = cvt_pk_bf16(v0[0], v0[1]); w.y = cvt_pk_bf16(v0[2], v0[3]); w.z = cvt_pk_bf16(v1[0], v1[1]); w.w = cvt_pk_bf16(v1[2], v1[3]);
                        *(u32x4*)(rowp + (size_t)bj * 16384 * 128) = w; } }
        }
    }
};
struct EpiRes {
    static constexpr bool PERM = false, AFTER_DRAIN = false;
    const float* X; float* O; float* SSQ;
    __device__ __forceinline__ void operator()(const f32x4 (&acc)[2][2][4][2], const Unit& u, int wr, int wc, int fr, int fq) const {
        const int row0 = u.pm * BM + wr * 64 + fr, col0 = u.pn * BM + wc * 32 + 4 * fq;
#pragma unroll
        for (int ai = 0; ai < 2; ++ai)
#pragma unroll
            for (int m = 0; m < 4; ++m) { const int r = row0 + ai * HALF + m * 16; const size_t off = (size_t)r * 1024 + col0; float ss = 0.f;
#pragma unroll
                for (int bj = 0; bj < 2; ++bj)
#pragma unroll
                    for (int n = 0; n < 2; ++n) { const f32x4 o = *(const f32x4*)(X + off + bj * HALF + n * 16) + acc[ai][bj][m][n];
                        *(f32x4*)(O + off + bj * HALF + n * 16) = o; ss += (o[0] * o[0] + o[1] * o[1]) + (o[2] * o[2] + o[3] * o[3]); }
                ss += __shfl_xor(ss, 16); ss += __shfl_xor(ss, 32);
                if (fq == 0) SSQ[(size_t)r * 16 + u.pn * 4 + wc] = ss;
                asm volatile("" ::: "memory"); }
    }
};
}
namespace pg8 {
struct UnitG : Unit { const char* aB; const char* bB; };
template <class Epi, class Sched>
__device__ __forceinline__ void gemm_phase_g(PG8_LAS unsigned char* lds, const int K, const Sched& S, const Epi& E) {
    const int tid = threadIdx.x, wid = __builtin_amdgcn_readfirstlane(tid >> 6), lane = tid & 63, wr = wid >> 2, wc = wid & 3, fr = lane & 15, fq = lane >> 4;
    const int nt = K / BK;
    unsigned voffB[2];
#pragma unroll
    for (int i = 0; i < 2; ++i) { int R, C; stage_rc(tid * 16 + i * 8192, R, C); const int Rb = Epi::PERM ? ((R & ~31) + perm32(R & 31)) : R;
        voffB[i] = (unsigned)(Rb * K + C) * 2u; }
    const size_t kstep = (size_t)(BK * 2);
    const size_t hstep = (size_t)HALF * K * 2;
    const unsigned ldsw = (unsigned)wid * 1024u;
    const int aoff = lds_byte(wr * 64 + fr, fq * 8), boff = lds_byte(wc * 32 + fr, fq * 8);
#define PG8_SA(b, h) (((b) * 2 + (h)) * HTB)
#define PG8_SB(b, h) ((4 + (b) * 2 + (h)) * HTB)
#define PG8_STAGE(bufoff, gbase, voff) do { _Pragma("unroll") for (int _i = 0; _i < 2; ++_i) \
        __builtin_amdgcn_global_load_lds((const unsigned*)((const char*)(gbase) + (voff)[_i]), (PG8_LAS unsigned*)(lds + (bufoff) + ldsw + _i * 8192), 16, 0, 0); } while (0)
#define PG8_LDA(dst, b, h) do { _Pragma("unroll") for (int m = 0; m < 4; ++m) _Pragma("unroll") for (int k = 0; k < 2; ++k) dst[m][k] = *(const PG8_LAS bf16x8*)(lds + PG8_SA(b, h) + aoff + m * 2048 + k * 1024); } while (0)
#define PG8_LDB(dst, b, h) do { _Pragma("unroll") for (int n = 0; n < 2; ++n) _Pragma("unroll") for (int k = 0; k < 2; ++k) dst[n][k] = *(const PG8_LAS bf16x8*)(lds + PG8_SB(b, h) + boff + n * 2048 + k * 1024); } while (0)
#define PG8_MMA(ai, bj, At, Bt) do { __builtin_amdgcn_s_setprio(1); _Pragma("unroll") for (int m = 0; m < 4; ++m) _Pragma("unroll") for (int n = 0; n < 2; ++n) _Pragma("unroll") for (int k = 0; k < 2; ++k) \
        acc[ai][bj][m][n] = __builtin_amdgcn_mfma_f32_16x16x32_bf16(Bt[n][k], At[m][k], acc[ai][bj][m][n], 0, 0, 0); __builtin_amdgcn_s_setprio(0); } while (0)
#define PG8_WAIT_V(n) asm volatile("s_waitcnt vmcnt(" #n ")" ::: "memory")
#define PG8_WAIT_L(n) asm volatile("s_waitcnt lgkmcnt(" #n ")" ::: "memory")
#define PG8_BAR __builtin_amdgcn_s_barrier()
#define PG8_SCHED __builtin_amdgcn_sched_barrier(0)
    UnitG cur, nxt; int ui = 0;
    if (!S.next(0, cur)) return;
    f32x4 acc[2][2][4][2];
#pragma unroll
    for (int a = 0; a < 2; ++a)
#pragma unroll
        for (int b = 0; b < 2; ++b)
#pragma unroll
            for (int m = 0; m < 4; ++m)
#pragma unroll
                for (int n = 0; n < 2; ++n) acc[a][b][m][n] = (f32x4){0.f, 0.f, 0.f, 0.f};
    bf16x8 At[4][2], B0[2][2], B1[2][2];
    unsigned curA[2][2], nxtA[2][2];
    S.a_offs(cur, tid, curA);
    const char* cA = cur.aB; const char* cB = cur.bB;
    PG8_STAGE(PG8_SB(0, 0), cB, voffB); PG8_STAGE(PG8_SB(0, 1), cB + hstep, voffB); PG8_STAGE(PG8_SA(0, 0), cA, curA[0]); PG8_STAGE(PG8_SA(0, 1), cA, curA[1]);
    if (wr == 1) PG8_BAR;
    PG8_WAIT_V(2); PG8_BAR;
    PG8_STAGE(PG8_SB(1, 0), cB + kstep, voffB); PG8_STAGE(PG8_SA(1, 0), cA + kstep, curA[0]); PG8_STAGE(PG8_SB(1, 1), cB + hstep + kstep, voffB);
    PG8_WAIT_V(6); PG8_BAR;
    for (;;) {
        const bool has_next = S.next(ui + 1, nxt);
        if (has_next) S.a_offs(nxt, tid, nxtA);
        else {
#pragma unroll
            for (int h = 0; h < 2; ++h)
#pragma unroll
                for (int i = 0; i < 2; ++i) nxtA[h][i] = curA[h][i]; }
        const char* nA = has_next ? nxt.aB : cA; const char* nB = has_next ? nxt.bB : cB;
#pragma unroll 1
        for (int t = 0; t < nt; t += 2) {
            const bool last = (t == nt - 2);
            const char* a1 = cA + (size_t)(t + 1) * kstep;
            const char* a2 = last ? nA : cA + (size_t)(t + 2) * kstep; const char* b2 = last ? nB : cB + (size_t)(t + 2) * kstep;
            const char* a3 = a2 + kstep; const char* b3 = b2 + kstep;
            unsigned oa2[2][2];
#pragma unroll
            for (int h = 0; h < 2; ++h)
#pragma unroll
                for (int i = 0; i < 2; ++i) oa2[h][i] = last ? nxtA[h][i] : curA[h][i];
            PG8_LDB(B0, 0, 0); PG8_LDB(B1, 0, 1); PG8_SCHED; PG8_LDA(At, 0, 0); PG8_STAGE(PG8_SA(1, 1), a1, curA[1]);
            PG8_WAIT_V(8); PG8_WAIT_L(0); PG8_BAR; PG8_MMA(0, 0, At, B0); PG8_MMA(0, 1, At, B1); PG8_BAR; PG8_SCHED;
            PG8_LDA(At, 0, 1); PG8_STAGE(PG8_SB(0, 0), b2, voffB); PG8_STAGE(PG8_SB(0, 1), b2 + hstep, voffB); PG8_STAGE(PG8_SA(0, 0), a2, oa2[0]);
            PG8_WAIT_V(8); PG8_WAIT_L(0); PG8_BAR; PG8_MMA(1, 0, At, B0); PG8_MMA(1, 1, At, B1); PG8_BAR; PG8_SCHED;
            PG8_LDB(B0, 1, 0); PG8_LDB(B1, 1, 1); PG8_SCHED; PG8_LDA(At, 1, 0); PG8_STAGE(PG8_SA(0, 1), a2, oa2[1]);
            PG8_WAIT_V(8); PG8_WAIT_L(0); PG8_BAR; PG8_MMA(0, 0, At, B0); PG8_MMA(0, 1, At, B1); PG8_BAR; PG8_SCHED;
            PG8_LDA(At, 1, 1); PG8_STAGE(PG8_SB(1, 0), b3, voffB); PG8_STAGE(PG8_SB(1, 1), b3 + hstep, voffB); PG8_STAGE(PG8_SA(1, 0), a3, oa2[0]);
            PG8_WAIT_V(8); PG8_WAIT_L(0); PG8_BAR; PG8_MMA(1, 0, At, B0); PG8_MMA(1, 1, At, B1); PG8_BAR; PG8_SCHED;
        }
        if (wr == 0) PG8_BAR;
        E(acc, cur, wr, wc, fr, fq);
        if (!has_next) break;
#pragma unroll
        for (int a = 0; a < 2; ++a)
#pragma unroll
            for (int b = 0; b < 2; ++b)
#pragma unroll
                for (int m = 0; m < 4; ++m)
#pragma unroll
                    for (int n = 0; n < 2; ++n) acc[a][b][m][n] = (f32x4){0.f, 0.f, 0.f, 0.f};
        cur = nxt; cA = nA; cB = nB; ++ui;
#pragma unroll
        for (int h = 0; h < 2; ++h)
#pragma unroll
            for (int i = 0; i < 2; ++i) curA[h][i] = nxtA[h][i];
        if (wr == 1) PG8_BAR;
    }
    PG8_WAIT_V(0);
    PG8_BAR;
#undef PG8_SA
#undef PG8_SB
#undef PG8_STAGE
#undef PG8_LDA
#undef PG8_LDB
#undef PG8_MMA
#undef PG8_WAIT_V
#undef PG8_WAIT_L
#undef PG8_BAR
#undef PG8_SCHED
}

struct MoeASched {
    const int* TILE; const int* ETOK; const char* H2; const char* WGU; int G, c;
    __device__ __forceinline__ bool next(int i, UnitG& u) const {
        const int L = i * G + c, nt = TILE[0]; if (L >= nt * 2) return false;
        const int ti = L >> 1, pn = L & 1, e = TILE[1 + ti];
        u.pm = ti; u.pn = pn; u.aB = H2; u.bB = WGU + ((size_t)e * 512 + pn * 256) * 2048; return true; }
    __device__ __forceinline__ void a_offs(const UnitG& u, int tid, unsigned (&o)[2][2]) const {
#pragma unroll
        for (int i = 0; i < 2; ++i) { int R, C; stage_rc(tid * 16 + i * 8192, R, C);
#pragma unroll
            for (int h = 0; h < 2; ++h) o[h][i] = (unsigned)ETOK[u.pm * 256 + h * 128 + R] * 2048u + (unsigned)C * 2u; } }
};
struct MoeBSched {
    const int* TILE; const char* ACT; const char* WDN; int G, c;
    __device__ __forceinline__ bool next(int i, UnitG& u) const {
        const int L = i * G + c, nt = TILE[0]; if (L >= nt * 4) return false;
        const int ti = L >> 2, pn = L & 3, e = TILE[1 + ti];
        u.pm = ti; u.pn = pn; u.aB = ACT + (size_t)ti * 256 * 512; u.bB = WDN + ((size_t)e * 1024 + pn * 256) * 512; return true; }
    __device__ __forceinline__ void a_offs(const UnitG&, int tid, unsigned (&o)[2][2]) const {
#pragma unroll
        for (int i = 0; i < 2; ++i) { int R, C; stage_rc(tid * 16 + i * 8192, R, C);
#pragma unroll
            for (int h = 0; h < 2; ++h) o[h][i] = (unsigned)((h * 128 + R) * 256 + C) * 2u; } }
};
struct EpiAct {
    static constexpr bool PERM = true, AFTER_DRAIN = false;
    bf16_t* ACT; const float* EW;
    __device__ __forceinline__ void operator()(const f32x4 (&acc)[2][2][4][2], const UnitG& u, int wr, int wc, int fr, int fq) const {
        const int row0 = u.pm * BM + wr * 64 + fr;
#pragma unroll
        for (int ai = 0; ai < 2; ++ai)
#pragma unroll
            for (int m = 0; m < 4; ++m) { const int r = row0 + ai * HALF + m * 16; const float w = EW[r];
                const f32x4 v0 = silu4(acc[ai][0][m][0]) * acc[ai][1][m][0] * w, v1 = silu4(acc[ai][0][m][1]) * acc[ai][1][m][1] * w;
                u32x4 o; o.x = cvt_pk_bf16(v0[0], v0[1]); o.y = cvt_pk_bf16(v0[2], v0[3]); o.z = cvt_pk_bf16(v1[0], v1[1]); o.w = cvt_pk_bf16(v1[2], v1[3]);
                *(u32x4*)(ACT + (size_t)r * 256 + u.pn * 128 + wc * 32 + 8 * fq) = o; }
    }
};
struct EpiYE {
    static constexpr bool PERM = true, AFTER_DRAIN = false;
    bf16_t* YE;
    __device__ __forceinline__ void operator()(const f32x4 (&acc)[2][2][4][2], const UnitG& u, int wr, int wc, int fr, int fq) const {
        const int row0 = u.pm * BM + wr * 64 + fr;
#pragma unroll
        for (int ai = 0; ai < 2; ++ai)
#pragma unroll
            for (int m = 0; m < 4; ++m) { bf16_t* rowp = YE + (size_t)(row0 + ai * HALF + m * 16) * 1024 + u.pn * BM + wc * 32 + 8 * fq;
#pragma unroll
                for (int bj = 0; bj < 2; ++bj) { const f32x4 v0 = acc[ai][bj][m][0], v1 = acc[ai][bj][m][1];
                    u32x4 o; o.x = cvt_pk_bf16(v0[0], v0[1]); o.y = cvt_pk_bf16(v0[2], v0[3]); o.z = cvt_pk_bf16(v1[0], v1[1]); o.w = cvt_pk_bf16(v1[2], v1[3]);
                    *(u32x4*)(rowp + bj * HALF) = o; } }
    }
};
}
namespace tl {
typedef short bf16x8 __attribute__((ext_vector_type(8)));
typedef short s16x4 __attribute__((ext_vector_type(4)));
typedef float f32x4 __attribute__((ext_vector_type(4)));
typedef unsigned u32x4 __attribute__((ext_vector_type(4)));
typedef unsigned u32x2 __attribute__((ext_vector_type(2)));
constexpr int TILE_BYTES = 32768;
constexpr int STAT_OFF = 131072 + 1024;
__device__ __forceinline__ unsigned off_b(unsigned row, unsigned ch) { return 256u * row + 16u * (ch ^ (((row & 3u) << 2) | ((row >> 2) & 3u))); }
__device__ __forceinline__ unsigned cvtpk(float lo, float hi) { return pg8::cvt_pk_bf16(lo, hi); }
__device__ __forceinline__ float blo(unsigned w) { return __uint_as_float(w << 16); }
__device__ __forceinline__ float bhi(unsigned w) { return __uint_as_float(w & 0xffff0000u); }

__device__ __forceinline__ void stage_plain(LAS unsigned char* tile, const bf16* g, size_t ld, int tid) {
#pragma unroll
    for (int i = 0; i < 4; ++i) { const int idx = tid + 512 * i, row = idx >> 4, ch = idx & 15;
        const u32x4 v = *(const u32x4*)(g + (size_t)row * ld + ch * 8);
        *(LAS u32x4*)(tile + off_b(row, ch)) = v; }
}
__device__ __forceinline__ u32x4 scale8(u32x4 v, float s) {
    u32x4 o; o.x = cvtpk(blo(v.x) * s, bhi(v.x) * s); o.y = cvtpk(blo(v.y) * s, bhi(v.y) * s); o.z = cvtpk(blo(v.z) * s, bhi(v.z) * s); o.w = cvtpk(blo(v.w) * s, bhi(v.w) * s); return o;
}
__device__ __forceinline__ void stage_decay(LAS unsigned char* tile, const bf16* g, size_t ld, int tid, float l2g) {
#pragma unroll
    for (int i = 0; i < 4; ++i) { const int idx = tid + 512 * i, row = idx >> 4, ch = idx & 15;
        const u32x4 v = *(const u32x4*)(g + (size_t)row * ld + ch * 8);
        *(LAS u32x4*)(tile + off_b(row, ch)) = scale8(v, exp2f((float)(127 - row) * l2g)); }
}
__device__ __forceinline__ void stage_rmsrow(LAS unsigned char* tile, const bf16* g, size_t ld, int tid) {
#pragma unroll
    for (int i = 0; i < 4; ++i) { const int idx = tid + 512 * i, row = idx >> 4, ch = idx & 15;
        const u32x4 v = *(const u32x4*)(g + (size_t)row * ld + ch * 8);
        float ss = (blo(v.x) * blo(v.x) + bhi(v.x) * bhi(v.x)) + (blo(v.y) * blo(v.y) + bhi(v.y) * bhi(v.y)) + (blo(v.z) * blo(v.z) + bhi(v.z) * bhi(v.z)) + (blo(v.w) * blo(v.w) + bhi(v.w) * bhi(v.w));
        ss += __shfl_xor(ss, 1); ss += __shfl_xor(ss, 2); ss += __shfl_xor(ss, 4); ss += __shfl_xor(ss, 8);
        *(LAS u32x4*)(tile + off_b(row, ch)) = scale8(v, 1.0f / sqrtf(ss * (1.0f / 128.0f) + EPS)); }
}
template <int NB> __device__ __forceinline__ void ld_row(const LAS unsigned char* tile, int rowbase, int fr, int fq, bf16x8 (&f)[NB][4]) {
#pragma unroll
    for (int i = 0; i < NB; ++i)
#pragma unroll
        for (int s = 0; s < 4; ++s) f[i][s] = *(const LAS bf16x8*)(tile + off_b(rowbase + 16 * i + fr, 4 * s + fq));
}
__device__ __forceinline__ void ld_tr(const LAS unsigned char* tile, int c, int lane, bf16x8 (&f)[4]) {
    const unsigned g = lane >> 4, q = (lane & 15) >> 2, p = lane & 3;
    const unsigned base = (unsigned)(size_t)tile;
    const unsigned a0 = base + off_b(8 * g + q, 2 * c + (p >> 1)) + 8 * (p & 1);
    const unsigned a1 = base + off_b(8 * g + 4 + q, 2 * c + (p >> 1)) + 8 * (p & 1);
    s16x4 l0, h0, l1, h1, l2, h2, l3, h3;
    asm volatile("ds_read_b64_tr_b16 %0, %8\n\tds_read_b64_tr_b16 %1, %9\n\t"
                 "ds_read_b64_tr_b16 %2, %8 offset:8192\n\tds_read_b64_tr_b16 %3, %9 offset:8192\n\t"
                 "ds_read_b64_tr_b16 %4, %8 offset:16384\n\tds_read_b64_tr_b16 %5, %9 offset:16384\n\t"
                 "ds_read_b64_tr_b16 %6, %8 offset:24576\n\tds_read_b64_tr_b16 %7, %9 offset:24576\n\t"
                 "s_waitcnt lgkmcnt(0)"
                 : "=&v"(l0), "=&v"(h0), "=&v"(l1), "=&v"(h1), "=&v"(l2), "=&v"(h2), "=&v"(l3), "=&v"(h3) : "v"(a0), "v"(a1) : "memory");
    f[0] = __builtin_shufflevector(l0, h0, 0, 1, 2, 3, 4, 5, 6, 7); f[1] = __builtin_shufflevector(l1, h1, 0, 1, 2, 3, 4, 5, 6, 7);
    f[2] = __builtin_shufflevector(l2, h2, 0, 1, 2, 3, 4, 5, 6, 7); f[3] = __builtin_shufflevector(l3, h3, 0, 1, 2, 3, 4, 5, 6, 7);
}
__device__ __forceinline__ void mma(f32x4 (&acc)[4][2], const bf16x8 (&A)[4][4], const bf16x8 (&B)[2][4]) {
#pragma unroll
    for (int s = 0; s < 4; ++s)
#pragma unroll
        for (int m = 0; m < 4; ++m)
#pragma unroll
            for (int n = 0; n < 2; ++n) acc[m][n] = __builtin_amdgcn_mfma_f32_16x16x32_bf16(B[n][s], A[m][s], acc[m][n], 0, 0, 0);
}
__device__ __forceinline__ void zero(f32x4 (&acc)[4][2]) {
#pragma unroll
    for (int m = 0; m < 4; ++m)
#pragma unroll
        for (int n = 0; n < 2; ++n) acc[m][n] = (f32x4){0.f, 0.f, 0.f, 0.f};
}

#define TL_BAR() do { asm volatile("s_waitcnt lgkmcnt(0)" ::: "memory"); __builtin_amdgcn_s_barrier(); asm volatile("" ::: "memory"); } while (0)
__device__ __forceinline__ void pf_tile(u32x4 (&r)[4], const bf16* g, int tid) {
#pragma unroll
    for (int i = 0; i < 4; ++i) r[i] = *(const u32x4*)(g + (size_t)(tid + 512 * i) * 8);
}
template <int NB> __device__ __forceinline__ void ldg_row(const bf16* g, int rowbase, int fr, int fq, bf16x8 (&f)[NB][4]) {
#pragma unroll
    for (int i = 0; i < NB; ++i)
#pragma unroll
        for (int s = 0; s < 4; ++s) f[i][s] = *(const bf16x8*)(g + (size_t)(rowbase + 16 * i + fr) * 128 + 32 * s + 8 * fq);
}

__device__ __forceinline__ void phase_kv(LAS unsigned char* lds, const bf16* PROJ, bf16* KVT, int bid, int G) {
    const int tid = threadIdx.x, lane = tid & 63, wid = __builtin_amdgcn_readfirstlane(tid >> 6), wr = wid >> 2, wc = wid & 3, fr = lane & 15, fq = lane >> 4;
    int u = bid; if (u >= 512) return;
    u32x4 pk[4], pv[4];
    { const int h = u & 3; const size_t t0 = (size_t)(u >> 8) * S_ + (size_t)((u >> 2) & 63) * CH;
      pf_tile(pk, PROJ + ((size_t)(4 + h) * T_ + t0) * 128, tid); pf_tile(pv, PROJ + ((size_t)(8 + h) * T_ + t0) * 128, tid); }
    int par = 0;
    for (;;) {
        LAS unsigned char* tK = lds + par * 2 * TILE_BYTES; LAS unsigned char* tV = tK + TILE_BYTES;
        const float l2g = log2_gamma(u & 3);
#pragma unroll
        for (int i = 0; i < 4; ++i) { const int idx = tid + 512 * i, row = idx >> 4, ch = idx & 15;
            *(LAS u32x4*)(tK + off_b(row, ch)) = scale8(pk[i], exp2f((float)(127 - row) * l2g));
            *(LAS u32x4*)(tV + off_b(row, ch)) = pv[i]; }
        TL_BAR();
        const int un = u + G; const bool has_next = un < 512;
        if (has_next) { const int h = un & 3; const size_t t0 = (size_t)(un >> 8) * S_ + (size_t)((un >> 2) & 63) * CH;
            pf_tile(pk, PROJ + ((size_t)(4 + h) * T_ + t0) * 128, tid); pf_tile(pv, PROJ + ((size_t)(8 + h) * T_ + t0) * 128, tid); }
        bf16x8 A[4][4], Bf[2][4];
#pragma unroll
        for (int m = 0; m < 4; ++m) ld_tr(tV, 4 * wr + m, lane, A[m]);
#pragma unroll
        for (int nn = 0; nn < 2; ++nn) ld_tr(tK, 2 * wc + nn, lane, Bf[nn]);
        f32x4 acc[4][2]; zero(acc); mma(acc, A, Bf);
        bf16* o = KVT + (size_t)u * 16384;
#pragma unroll
        for (int m = 0; m < 4; ++m)
#pragma unroll
            for (int nn = 0; nn < 2; ++nn) { u32x2 w; w.x = cvtpk(acc[m][nn][0], acc[m][nn][1]); w.y = cvtpk(acc[m][nn][2], acc[m][nn][3]);
                *(u32x2*)(o + (64 * wr + 16 * m + fr) * 128 + 32 * wc + 16 * nn + 4 * fq) = w; }
        if (!has_next) break;
        u = un; par ^= 1;
    }
    TL_BAR();
}
__device__ __forceinline__ void phase_sgu(LAS unsigned char* lds, const bf16* PROJ, const bf16* WSM, const float* bs, const float* gain, bf16* MIX, int bid, int G) {
    const int tid = threadIdx.x, lane = tid & 63, wid = __builtin_amdgcn_readfirstlane(tid >> 6), wr = wid >> 2, wc = wid & 3, fr = lane & 15, fq = lane >> 4;
    int u = bid; if (u >= 512) return;
    u32x4 pv[4]; u32x2 uu[4][2];
    { const int g = u & 3; const size_t t0 = (size_t)(u >> 8) * S_ + (size_t)((u >> 2) & 63) * CH;
      pf_tile(pv, PROJ + ((size_t)(20 + g) * T_ + t0) * 128, tid);
#pragma unroll
      for (int m = 0; m < 4; ++m)
#pragma unroll
          for (int nn = 0; nn < 2; ++nn) uu[m][nn] = *(const u32x2*)(PROJ + ((size_t)(16 + g) * T_ + t0 + 64 * wr + 16 * m + fr) * 128 + 32 * wc + 16 * nn + 4 * fq); }
    int par = 0, gcur = -1;
    bf16x8 A[4][4]; f32x4 gn[2]; float bi[4];
    for (;;) {
        LAS unsigned char* tV = lds + par * TILE_BYTES;
        const int g = u & 3; const size_t t0 = (size_t)(u >> 8) * S_ + (size_t)((u >> 2) & 63) * CH;
        if (g != gcur) {
            gcur = g; ldg_row<4>(WSM + (size_t)g * 16384, 64 * wr, fr, fq, A);
#pragma unroll
            for (int nn = 0; nn < 2; ++nn) gn[nn] = *(const f32x4*)(gain + g * 128 + 32 * wc + 16 * nn + 4 * fq);
#pragma unroll
            for (int m = 0; m < 4; ++m) bi[m] = bs[g * 128 + 64 * wr + 16 * m + fr];
        }
#pragma unroll
        for (int i = 0; i < 4; ++i) { const int idx = tid + 512 * i, row = idx >> 4, ch = idx & 15; const u32x4 v = pv[i];
            float ss = (blo(v.x) * blo(v.x) + bhi(v.x) * bhi(v.x)) + (blo(v.y) * blo(v.y) + bhi(v.y) * bhi(v.y)) + (blo(v.z) * blo(v.z) + bhi(v.z) * bhi(v.z)) + (blo(v.w) * blo(v.w) + bhi(v.w) * bhi(v.w));
            ss += __shfl_xor(ss, 1); ss += __shfl_xor(ss, 2); ss += __shfl_xor(ss, 4); ss += __shfl_xor(ss, 8);
            *(LAS u32x4*)(tV + off_b(row, ch)) = scale8(v, 1.0f / sqrtf(ss * (1.0f / 128.0f) + EPS)); }
        TL_BAR();
        u32x2 uc[4][2];
#pragma unroll
        for (int m = 0; m < 4; ++m)
#pragma unroll
            for (int nn = 0; nn < 2; ++nn) uc[m][nn] = uu[m][nn];
        const int un = u + G; const bool has_next = un < 512;
        if (has_next) { const int g2 = un & 3; const size_t t2 = (size_t)(un >> 8) * S_ + (size_t)((un >> 2) & 63) * CH;
            pf_tile(pv, PROJ + ((size_t)(20 + g2) * T_ + t2) * 128, tid);
#pragma unroll
            for (int m = 0; m < 4; ++m)
#pragma unroll
                for (int nn = 0; nn < 2; ++nn) uu[m][nn] = *(const u32x2*)(PROJ + ((size_t)(16 + g2) * T_ + t2 + 64 * wr + 16 * m + fr) * 128 + 32 * wc + 16 * nn + 4 * fq); }
        bf16x8 Bf[2][4];
#pragma unroll
        for (int nn = 0; nn < 2; ++nn) ld_tr(tV, 2 * wc + nn, lane, Bf[nn]);
        f32x4 acc[4][2]; zero(acc); mma(acc, A, Bf);
#pragma unroll
        for (int m = 0; m < 4; ++m) { const int i = 64 * wr + 16 * m + fr;
#pragma unroll
            for (int nn = 0; nn < 2; ++nn) { const int c = 32 * wc + 16 * nn + 4 * fq;
                const f32x4 sv = acc[m][nn] * gn[nn] + bi[m];
                u32x2 o; o.x = cvtpk(blo(uc[m][nn].x) * sv[0], bhi(uc[m][nn].x) * sv[1]); o.y = cvtpk(blo(uc[m][nn].y) * sv[2], bhi(uc[m][nn].y) * sv[3]);
                *(u32x2*)(MIX + (t0 + i) * D_ + 512 + g * 128 + c) = o; } }
        if (!has_next) break;
        u = un; par ^= 1;
    }
    TL_BAR();
}
__device__ __forceinline__ void phase_ret(LAS unsigned char* lds, const bf16* PROJ, const bf16* ST, const float* gn_gain, bf16* MIX, int bid, int G) {
    const int tid = threadIdx.x, lane = tid & 63, wid = __builtin_amdgcn_readfirstlane(tid >> 6), wr = wid >> 2, wc = wid & 3, fr = lane & 15, fq = lane >> 4;
    int u = bid; if (u >= 512) return;
    u32x4 pv[4];
    { const int h = u & 3; const size_t t0 = (size_t)(u >> 8) * S_ + (size_t)((u >> 2) & 63) * CH; pf_tile(pv, PROJ + ((size_t)(8 + h) * T_ + t0) * 128, tid); }
    int par = 0;
    for (;;) {
        LAS unsigned char* tV = lds + par * 2 * TILE_BYTES; LAS unsigned char* tP = tV + TILE_BYTES;
        LAS float* stat = (LAS float*)(lds + 4 * TILE_BYTES + 1024 + par * 4096);
        const int h = u & 3; const size_t t0 = (size_t)(u >> 8) * S_ + (size_t)((u >> 2) & 63) * CH;
        const float l2g = log2_gamma(h);
        bf16x8 A[4][4], Bs[2][4], Bk[2][4];
        ldg_row<4>(PROJ + ((size_t)(0 + h) * T_ + t0) * 128, 64 * wr, fr, fq, A);
        ldg_row<2>(ST + (size_t)u * 16384, 32 * wc, fr, fq, Bs);
        ldg_row<2>(PROJ + ((size_t)(4 + h) * T_ + t0) * 128, 32 * wc, fr, fq, Bk);
#pragma unroll
        for (int i = 0; i < 4; ++i) { const int idx = tid + 512 * i; *(LAS u32x4*)(tV + off_b(idx >> 4, idx & 15)) = pv[i]; }
        { f32x4 accS[4][2]; zero(accS); mma(accS, A, Bk);
#pragma unroll
          for (int m = 0; m < 4; ++m) { const int i = 64 * wr + 16 * m + fr;
#pragma unroll
              for (int nn = 0; nn < 2; ++nn) { const int j0 = 32 * wc + 16 * nn + 4 * fq; float pvv[4];
#pragma unroll
                  for (int v = 0; v < 4; ++v) { const int dd = i - (j0 + v); pvv[v] = dd >= 0 ? accS[m][nn][v] * exp2f((float)dd * l2g) : 0.f; }
                  u32x2 o; o.x = cvtpk(pvv[0], pvv[1]); o.y = cvtpk(pvv[2], pvv[3]);
                  *(LAS u32x2*)(tP + off_b(i, 4 * wc + 2 * nn + (fq >> 1)) + 8 * (fq & 1)) = o; } } }
        f32x4 accO[4][2]; zero(accO); mma(accO, A, Bs);
#pragma unroll
        for (int m = 0; m < 4; ++m) { const float qd = exp2f((float)(64 * wr + 16 * m + fr + 1) * l2g);
#pragma unroll
            for (int nn = 0; nn < 2; ++nn) accO[m][nn] *= qd; }
        TL_BAR();
        const int un = u + G; const bool has_next = un < 512;
        if (has_next) { const int h2 = un & 3; const size_t t2 = (size_t)(un >> 8) * S_ + (size_t)((un >> 2) & 63) * CH; pf_tile(pv, PROJ + ((size_t)(8 + h2) * T_ + t2) * 128, tid); }
        u32x2 gt[4][2]; f32x4 gg[2];
#pragma unroll
        for (int nn = 0; nn < 2; ++nn) gg[nn] = *(const f32x4*)(gn_gain + h * 128 + 32 * wc + 16 * nn + 4 * fq);
#pragma unroll
        for (int m = 0; m < 4; ++m)
#pragma unroll
            for (int nn = 0; nn < 2; ++nn) gt[m][nn] = *(const u32x2*)(PROJ + ((size_t)(12 + h) * T_ + t0 + 64 * wr + 16 * m + fr) * 128 + 32 * wc + 16 * nn + 4 * fq);
        ld_row<4>(tP, 64 * wr, fr, fq, A);
#pragma unroll
        for (int nn = 0; nn < 2; ++nn) ld_tr(tV, 2 * wc + nn, lane, Bs[nn]);
        mma(accO, A, Bs);
#pragma unroll
        for (int m = 0; m < 4; ++m) { float sm = 0.f, q = 0.f;
#pragma unroll
            for (int nn = 0; nn < 2; ++nn) { const f32x4 x = accO[m][nn]; sm += (x[0] + x[1]) + (x[2] + x[3]); q += (x[0] * x[0] + x[1] * x[1]) + (x[2] * x[2] + x[3] * x[3]); }
            sm += __shfl_xor(sm, 16); sm += __shfl_xor(sm, 32); q += __shfl_xor(q, 16); q += __shfl_xor(q, 32);
            if (fq == 0) { const int i = 64 * wr + 16 * m + fr; stat[(i * 4 + wc) * 2] = sm; stat[(i * 4 + wc) * 2 + 1] = q; } }
        TL_BAR();
#pragma unroll
        for (int m = 0; m < 4; ++m) { const int i = 64 * wr + 16 * m + fr;
            const f32x4 p0 = *(const LAS f32x4*)(stat + i * 8), p1 = *(const LAS f32x4*)(stat + i * 8 + 4);
            const float mu = ((p0[0] + p0[2]) + (p1[0] + p1[2])) * (1.0f / 128.0f);
            const float var = fmaxf(((p0[1] + p0[3]) + (p1[1] + p1[3])) * (1.0f / 128.0f) - mu * mu, 0.f);
            const float rstd = 1.0f / sqrtf(var + EPS);
#pragma unroll
            for (int nn = 0; nn < 2; ++nn) { const int e = 32 * wc + 16 * nn + 4 * fq;
                const f32x4 y = (accO[m][nn] - mu) * rstd * gg[nn];
                u32x2 o; o.x = cvtpk(y[0] * blo(gt[m][nn].x), y[1] * bhi(gt[m][nn].x)); o.y = cvtpk(y[2] * blo(gt[m][nn].y), y[3] * bhi(gt[m][nn].y));
                *(u32x2*)(MIX + (t0 + i) * D_ + h * 128 + e) = o; } }
        if (!has_next) break;
        u = un; par ^= 1;
    }
    TL_BAR();
}
#undef TL_BAR
}
namespace rt {
typedef short bf16x8 __attribute__((ext_vector_type(8)));
typedef float f32x4 __attribute__((ext_vector_type(4)));
typedef unsigned u32x4 __attribute__((ext_vector_type(4)));
constexpr int PSTR = 49;
__device__ __forceinline__ void ph_router(LAS unsigned char* lds, const float* X1, const float* SSQ, const float* gain, const bf16* WRT, const float* brg, const float* bre,
                                          bf16* H2, int4* ROUTE, int* CNT, int bid, int nblk) {
    const int tid = threadIdx.x, lane = tid & 63, wid = __builtin_amdgcn_readfirstlane(tid >> 6), fr = lane & 15, fq = lane >> 4;
    const int rb = wid & 3, kh = wid >> 2;
    LAS float* part = (LAS float*)lds;
    for (int c = bid; c < T_ / 64; c += nblk) {
        const int row = c * 64 + 16 * rb + fr;
        float ss = 0.f;
        { const f32x4* sp = (const f32x4*)(SSQ + (size_t)row * 16);
#pragma unroll
          for (int i = 0; i < 4; ++i) { const f32x4 v = sp[i]; ss += (v[0] + v[1]) + (v[2] + v[3]); } }
        const float rstd = 1.0f / sqrtf(ss * (1.0f / D_) + EPS);
        f32x4 acc[3];
#pragma unroll
        for (int i = 0; i < 3; ++i) acc[i] = (f32x4){0.f, 0.f, 0.f, 0.f};
        const float* xr = X1 + (size_t)row * D_ + 512 * kh + 8 * fq;
        const float* gr = gain + 512 * kh + 8 * fq;
        const bf16* wr0 = WRT + (size_t)fr * D_ + 512 * kh + 8 * fq;
        bf16* hr = H2 + (size_t)row * D_ + 512 * kh + 8 * fq;
#pragma unroll 8
        for (int kc = 0; kc < 16; ++kc) {
            const f32x4 x0 = *(const f32x4*)(xr + 32 * kc), x1 = *(const f32x4*)(xr + 32 * kc + 4);
            const f32x4 g0 = *(const f32x4*)(gr + 32 * kc), g1 = *(const f32x4*)(gr + 32 * kc + 4);
            bf16x8 bh[3], bl[3];
#pragma unroll
            for (int nt = 0; nt < 3; ++nt) { bh[nt] = *(const bf16x8*)(wr0 + (size_t)(16 * nt) * D_ + 32 * kc); bl[nt] = *(const bf16x8*)(wr0 + (size_t)(48 + 16 * nt) * D_ + 32 * kc); }
            float hn[8];
#pragma unroll
            for (int j = 0; j < 4; ++j) { hn[j] = x0[j] * rstd * g0[j]; hn[4 + j] = x1[j] * rstd * g1[j]; }
            u32x4 hi, lo;
            hi.x = pk2(hn[0], hn[1]); hi.y = pk2(hn[2], hn[3]); hi.z = pk2(hn[4], hn[5]); hi.w = pk2(hn[6], hn[7]);
            lo.x = pk2(hn[0] - __uint_as_float(hi.x << 16), hn[1] - __uint_as_float(hi.x & 0xffff0000u));
            lo.y = pk2(hn[2] - __uint_as_float(hi.y << 16), hn[3] - __uint_as_float(hi.y & 0xffff0000u));
            lo.z = pk2(hn[4] - __uint_as_float(hi.z << 16), hn[5] - __uint_as_float(hi.z & 0xffff0000u));
            lo.w = pk2(hn[6] - __uint_as_float(hi.w << 16), hn[7] - __uint_as_float(hi.w & 0xffff0000u));
            *(u32x4*)(hr + 32 * kc) = hi;
            const bf16x8 ah = __builtin_bit_cast(bf16x8, hi), al = __builtin_bit_cast(bf16x8, lo);
#pragma unroll
            for (int nt = 0; nt < 3; ++nt) {
                acc[nt] = __builtin_amdgcn_mfma_f32_16x16x32_bf16(bh[nt], ah, acc[nt], 0, 0, 0);
                acc[nt] = __builtin_amdgcn_mfma_f32_16x16x32_bf16(bh[nt], al, acc[nt], 0, 0, 0);
                acc[nt] = __builtin_amdgcn_mfma_f32_16x16x32_bf16(bl[nt], ah, acc[nt], 0, 0, 0);
            }
        }
#pragma unroll
        for (int nt = 0; nt < 3; ++nt)
#pragma unroll
            for (int v = 0; v < 4; ++v) part[(kh * 64 + 16 * rb + fr) * PSTR + 16 * nt + 4 * fq + v] = acc[nt][v];
        __syncthreads();
        if (wid == 0) {
            const LAS float* p0 = part + lane * PSTR; const LAS float* p1 = part + (64 + lane) * PSTR;
            float lg[4], le[4][8];
#pragma unroll
            for (int g = 0; g < 4; ++g) { lg[g] = p0[32 + g] + p1[32 + g] + brg[g];
#pragma unroll
                for (int e = 0; e < 8; ++e) le[g][e] = p0[g * 8 + e] + p1[g * 8 + e] + bre[g * 8 + e]; }
            int e1, e2; float w1, w2; route_decide(lg, le, e1, e2, w1, w2);
            int r1 = 0, r2 = 0, mycnt = 0;
            const unsigned long long lt = (1ull << lane) - 1ull;
            for (int e = 0; e < NEXP; ++e) {
                const unsigned long long m = __ballot(e1 == e || e2 == e);
                const int below = __popcll(m & lt);
                if (e1 == e) r1 = below;
                if (e2 == e) r2 = below;
                if (lane == e) mycnt = __popcll(m);
            }
            ROUTE[c * 64 + lane] = make_int4(e1 | (r1 << 8), e2 | (r2 << 8), __float_as_int(w1), __float_as_int(w2));
            if (lane < NEXP) CNT[c * NEXP + lane] = mycnt;
        }
        __syncthreads();
    }
}
}
#define XB_TMO      128
#define XB_XCNT(j)  (256  + 64 * (j))
#define XB_XSUB(j)  (1280 + 64 * (j))
#define XB_XGEN(j)  (2304 + 64 * (j))
#define XB_TOP      3328
#define XB_TOPGEN   3392
#define XCD_BAR_WORDS 3456
#define XB_SPIN_CAP (1u << 18)

__device__ __forceinline__ unsigned xb_ld(unsigned* p)              { return __hip_atomic_load(p, __ATOMIC_RELAXED, __HIP_MEMORY_SCOPE_AGENT); }
__device__ __forceinline__ unsigned xb_add(unsigned* p, unsigned v) { return __hip_atomic_fetch_add(p, v, __ATOMIC_RELAXED, __HIP_MEMORY_SCOPE_AGENT); }
__device__ __forceinline__ unsigned xb_xcc_id() { return (unsigned)__builtin_amdgcn_s_getreg((3 << 11) | 20) & 0xFu; }
#define XB_SPIN(cond, bar) do { unsigned _sp = 0; while (cond) { __builtin_amdgcn_s_sleep(1); \
    if ((++_sp & 255u) == 0u) { if (xb_ld(&(bar)[XB_TMO])) break; if (_sp > XB_SPIN_CAP) { atomicAdd(&(bar)[XB_TMO], 1u); break; } } } } while (0)

struct XcdBarrier {
    unsigned* bar; unsigned x;
    volatile LAS unsigned* st;
};

__device__ __forceinline__ XcdBarrier xcd_barrier_post(unsigned* bar, volatile LAS unsigned* st) {
    XcdBarrier b; b.bar = bar; b.x = xb_xcc_id(); b.st = st;
    if (threadIdx.x == 0) (void)xb_add(&bar[XB_XCNT(b.x)], 1u);
    return b;
}
__device__ __forceinline__ void xcd_barrier_complete(unsigned* bar, unsigned x, unsigned& nloc, unsigned& nx) {
    const unsigned G = gridDim.x * gridDim.y * gridDim.z;
    unsigned sum, cnt, mine, sp = 0u;
    for (;;) {
        sum = 0u; cnt = 0u; mine = 0u;
#pragma unroll
        for (unsigned j = 0; j < 16; ++j) { const unsigned c = xb_ld(&bar[XB_XCNT(j)]); sum += c; cnt += (c > 0u) ? 1u : 0u; mine = (j == x) ? c : mine; }
        if (sum == G) break;
        __builtin_amdgcn_s_sleep(1);
        if ((++sp & 255u) == 0u) { if (xb_ld(&bar[XB_TMO])) break; if (sp > XB_SPIN_CAP) { atomicAdd(&bar[XB_TMO], 1u); break; } }
    }
    nloc = mine > 0u ? mine : 1u; nx = cnt > 0u ? cnt : 1u;
}

__device__ __forceinline__ void xcd_barrier(const XcdBarrier& b) {
    asm volatile("s_waitcnt vmcnt(0)" ::: "memory");
    __syncthreads();
    if (threadIdx.x == 0) {
        unsigned* bar = b.bar;
        __builtin_amdgcn_s_waitcnt(0);
        unsigned nloc = b.st[0], nx = b.st[1];
        if (nloc == 0u) { xcd_barrier_complete(bar, b.x, nloc, nx); b.st[0] = nloc; b.st[1] = nx; }
        const unsigned old = xb_add(&bar[XB_XSUB(b.x)], 1u);
        const unsigned gen = old / nloc;
        if (old + 1u == (gen + 1u) * nloc) {
            __builtin_amdgcn_fence(__ATOMIC_RELEASE, "agent");
            asm volatile("s_waitcnt vmcnt(0)" ::: "memory");
            const unsigned og = xb_add(&bar[XB_TOP], 1u);
            const unsigned tg = og / nx;
            if (og + 1u == (tg + 1u) * nx) xb_add(&bar[XB_TOPGEN], 1u);
            else XB_SPIN(xb_ld(&bar[XB_TOPGEN]) == tg, bar);
            __builtin_amdgcn_fence(__ATOMIC_ACQUIRE, "agent");
            xb_add(&bar[XB_XGEN(b.x)], 1u);
            asm volatile("s_waitcnt vmcnt(0)" ::: "memory");
        } else {
            XB_SPIN(xb_ld(&bar[XB_XGEN(b.x)]) == gen, bar);
            __builtin_amdgcn_fence(__ATOMIC_ACQUIRE, "agent");
            asm volatile("s_waitcnt vmcnt(0)" ::: "memory");
        }
    }
    __syncthreads();
}
constexpr int NWAVES = 8;
constexpr int RING_OFF = 0, RING_BYTES = 131072;
constexpr int LDSCTL_OFF = RING_BYTES, MISC_OFF = LDSCTL_OFF + 320;
constexpr int LDS_BYTES = 147456;
constexpr int CW_BAR = 4096;
constexpr size_t CTL_ZERO_BYTES = 64 * 1024;
static_assert((CW_BAR + XCD_BAR_WORDS) * 4 <= (int)CTL_ZERO_BYTES, "ctl");
#define LDS_WAIT() asm volatile("s_waitcnt lgkmcnt(0)" ::: "memory")

struct Args { P p; int ph_lo, ph_hi; };

template <class RowMap>
__device__ __forceinline__ void tr_item(const float* W, int K, int N, bf16* WT, LAS float* scr, int item, int lane, RowMap rm) {
    const int nblk = N / 32, kb = item / nblk, nb = item % nblk, k0 = 64 * kb, n0 = 32 * nb;
    float wv[32];
#pragma unroll
    for (int i = 0; i < 32; ++i) { const int kk = 2 * i + (lane >> 5); wv[i] = W[(size_t)(k0 + kk) * N + n0 + (lane & 31)]; }
#pragma unroll
    for (int i = 0; i < 32; ++i) { const int kk = 2 * i + (lane >> 5); scr[kk * 33 + (lane & 31)] = wv[i]; }
    LDS_WAIT(); asm volatile("" ::: "memory");
    const int c = lane & 7;
#pragma unroll
    for (int j = 0; j < 4; ++j) { const int n = (lane >> 3) + 8 * j; const LAS float* s = scr + (8 * c) * 33 + n;
        pg8::u32x4 o; o.x = pk2(s[0 * 33], s[1 * 33]); o.y = pk2(s[2 * 33], s[3 * 33]); o.z = pk2(s[4 * 33], s[5 * 33]); o.w = pk2(s[6 * 33], s[7 * 33]);
        *(pg8::u32x4*)(WT + (size_t)rm(n0 + n) * K + k0 + 8 * c) = o; }
    LDS_WAIT(); asm volatile("" ::: "memory");
}
struct RmId { __device__ __forceinline__ int operator()(int n) const { return n; } };
struct RmQK { __device__ __forceinline__ int operator()(int a) const { return a >= 1024 ? a : ((a & ~127) | (((a >> 4) & 3) << 5) | (((a >> 2) & 3) << 3) | (((a >> 6) & 1) << 2) | (a & 3)); } };
struct RmGU { int add; __device__ __forceinline__ int operator()(int f) const { return 256 * (f >> 7) + add + (f & 127); } };

__device__ __forceinline__ void ph_prologue(const P& p, LAS unsigned char* lds, int bid, int nblk) {
    const int tid = threadIdx.x, lane = tid & 63, wave = __builtin_amdgcn_readfirstlane(tid >> 6);
    const int gw = bid * NWAVES + wave, ngw = nblk * NWAVES, gt = bid * (NWAVES * 64) + tid, ngt = nblk * NWAVES * 64;
    unsigned char* ws = p.ws;
    LAS float* scr = (LAS float*)(lds + wave * 16384);
    bf16* WIN_T = (bf16*)(ws + WS_WIN_T); bf16* WOUT_T = (bf16*)(ws + WS_WOUT_T); bf16* WGU_T = (bf16*)(ws + WS_WGU_T); bf16* WDN_T = (bf16*)(ws + WS_WDN_T);
    constexpr int I_IN = 16 * 96, I_OUT = 16 * 32, I_E = 128, NITEMS = I_IN + I_OUT + NEXP * 3 * I_E;
    for (int it = gw; it < NITEMS; it += ngw) {
        int r = it;
        if (r < I_IN) { tr_item(p.w_in, D_, NIN, WIN_T, scr, r, lane, RmQK{}); continue; } r -= I_IN;
        if (r < I_OUT) { tr_item(p.w_out, D_, D_, WOUT_T, scr, r, lane, RmId{}); continue; } r -= I_OUT;
        const int e = r / (3 * I_E), q = r % (3 * I_E);
        if (q < I_E) tr_item(p.w_gu + (size_t)e * D_ * FF, D_, FF, WGU_T + (size_t)e * 512 * D_, scr, q, lane, RmGU{0});
        else if (q < 2 * I_E) tr_item(p.w_up + (size_t)e * D_ * FF, D_, FF, WGU_T + (size_t)e * 512 * D_, scr, q - I_E, lane, RmGU{128});
        else tr_item(p.w_dn + (size_t)e * FF * D_, FF, D_, WDN_T + (size_t)e * D_ * FF, scr, q - 2 * I_E, lane, RmId{});
    }
    ph_rmsnorm_bf16(p.x, p.g_mix, (bf16*)(ws + WS_H), gw, ngw, lane);
    { float* COS = (float*)(ws + WS_ROPE); float* SIN = COS + (size_t)T_ * 64;
      for (int i = gt; i < T_ * 64; i += ngt) { const int t = i >> 6, j = i & 63; float sn, cs; sincosf((float)p.pos[t] * inv_freq(j), &sn, &cs); COS[i] = cs; SIN[i] = sn; } }
    { bf16* WSM = (bf16*)(ws + WS_WSM);
      for (int i = gt; i < 4 * 128 * 128; i += ngt) { const int jj = i & 127, ii = (i >> 7) & 127; WSM[i] = jj <= ii ? f2bf(p.sgu_w[i]) : (bf16)0; }
      bf16* WRT = (bf16*)(ws + WS_WRT);
      for (int i = gt; i < 48 * 1024; i += ngt) { const int o = i >> 10, k = i & 1023;
          const float w = o < 32 ? p.w_re[((size_t)(o >> 3) * D_ + k) * 8 + (o & 7)] : (o < 36 ? p.w_rg[k * 4 + (o - 32)] : 0.f);
          const bf16 hi = f2bf(w); WRT[i] = hi; WRT[48 * 1024 + i] = f2bf(w - bf2f(hi)); } }
}

__global__ void __launch_bounds__(NWAVES * 64, 2) mk_fwd(Args args) {
    extern __shared__ __attribute__((aligned(16))) unsigned char lds_raw[];
    LAS unsigned char* lds = (LAS unsigned char*)lds_raw;
    volatile LAS unsigned* MISC = (volatile LAS unsigned*)(lds + MISC_OFF);
    const P& p = args.p;
    const int tid = threadIdx.x, lane = tid & 63, wave = __builtin_amdgcn_readfirstlane(tid >> 6);
    const int G = gridDim.x, bid = blockIdx.x;
    const int gw = bid * NWAVES + wave, ngw = G * NWAVES, gt = bid * (NWAVES * 64) + tid, ngt = G * NWAVES * 64;
    unsigned char* ws = p.ws;
    for (int u = tid; u < (LDS_BYTES - LDSCTL_OFF) / 4; u += NWAVES * 64) ((LAS unsigned*)(lds + LDSCTL_OFF))[u] = 0u;
    __syncthreads();
    const int lo = args.ph_lo, hi = args.ph_hi;
    XcdBarrier bar; bar.bar = (unsigned*)(ws + WS_CTL) + CW_BAR; bar.x = 0; bar.st = nullptr;
    if (hi - lo > 1) bar = xcd_barrier_post((unsigned*)(ws + WS_CTL) + CW_BAR, MISC + 8);
#ifndef DUP_PHASE
#define DUP_PHASE -1
#endif
#define IN(k) (lo <= (k) && (k) < hi)
#define PH(k) for (int rep_ = 0; rep_ < ((DUP_PHASE == (k)) ? 2 : 1); ++rep_)
#define SEAM(k) do { if (IN(k) && IN((k) + 1)) xcd_barrier(bar); } while (0)

    bf16* H = (bf16*)(ws + WS_H); bf16* PROJ = (bf16*)(ws + WS_PROJ); bf16* KVT = (bf16*)(ws + WS_KVT); bf16* ST = (bf16*)(ws + WS_ST); bf16* MIX = (bf16*)(ws + WS_MIX);
    float* SSQ = (float*)(ws + WS_SSQ); int4* ROUTE = (int4*)(ws + WS_ROUTE); int* CNT = (int*)(ws + WS_CNT); int* ETOK = (int*)(ws + WS_ETOK); float* EW = (float*)(ws + WS_EW);
    int2* TOKPOS = (int2*)(ws + WS_TOKPOS); int* TILE = (int*)(ws + WS_TILE); bf16* YE = (bf16*)(ws + WS_YE);

    if (IN(0)) PH(0) { ph_prologue(p, lds, bid, G); SEAM(0); }
    if (IN(1)) PH(1) {
        pg8::Gemm g{H, (const bf16*)(ws + WS_WIN_T), T_, NIN, D_}; pg8::StaticOrder S; S.init(T_, NIN, G, bid);
        pg8::EpiProj E{PROJ, (const float*)(ws + WS_ROPE), (const float*)(ws + WS_ROPE) + (size_t)T_ * 64};
        pg8::gemm_phase<pg8::EpiProj, pg8::StaticOrder, true, true>(lds + RING_OFF, g, S, E);
        SEAM(1);
    }
    if (IN(2)) PH(2) {
        tl::phase_kv(lds, PROJ, KVT, bid, G);
        tl::phase_sgu(lds, PROJ, (const bf16*)(ws + WS_WSM), p.sgu_b, p.sgu_gain, MIX, bid, G);
        SEAM(2);
    }
    if (IN(3)) PH(3) { ph_scan(KVT, ST, gt, ngt); SEAM(3); }
    if (IN(4)) PH(4) { tl::phase_ret(lds, PROJ, ST, p.gn_gain, MIX, bid, G); SEAM(4); }
    if (IN(5)) PH(5) {
        pg8::Gemm g{MIX, (const bf16*)(ws + WS_WOUT_T), T_, D_, D_}; pg8::StaticOrder S; S.init(T_, D_, G, bid);
        pg8::EpiRes E{p.x, p.out, SSQ};
        pg8::gemm_phase<pg8::EpiRes, pg8::StaticOrder, true, true>(lds + RING_OFF, g, S, E);
        SEAM(5);
    }
    if (IN(6)) PH(6) { rt::ph_router(lds, p.out, SSQ, p.g_ffn, (const bf16*)(ws + WS_WRT), p.b_rg, p.b_re, H, ROUTE, CNT, bid, G); SEAM(6); }
    if (IN(7)) PH(7) { __syncthreads(); ph_lists(ROUTE, CNT, ETOK, EW, TOKPOS, TILE, (int*)lds_raw, bid, G); SEAM(7); }
    if (IN(8)) PH(8) {
        pg8::MoeASched S{TILE, ETOK, (const char*)H, (const char*)(ws + WS_WGU_T), G, bid}; pg8::EpiAct E{(bf16*)(ws + WS_ACT), EW};
        pg8::gemm_phase_g<pg8::EpiAct, pg8::MoeASched>(lds + RING_OFF, D_, S, E);
        SEAM(8);
    }
    if (IN(9)) PH(9) {
        pg8::MoeBSched S{TILE, (const char*)(ws + WS_ACT), (const char*)(ws + WS_WDN_T), G, bid}; pg8::EpiYE E{YE};
        pg8::gemm_phase_g<pg8::EpiYE, pg8::MoeBSched>(lds + RING_OFF, FF, S, E);
        SEAM(9);
    }
    if (IN(10)) { ph_final(p.out, YE, TOKPOS, p.g_fin, gw, ngw, lane); }
#undef IN
#undef PH
#undef SEAM
}

extern "C" void kernel_launch(void* const* d_in, const int* in_sizes, int n_in, void* d_out, int out_size, void* d_ws, size_t ws_size, hipStream_t stream) {
    static int grid = 0;
    if (grid == 0) {
        if (n_in != 18 || ws_size < WS_END) fprintf(stderr, "kernel_launch: unexpected n_in %d / ws_size %zu\n", n_in, ws_size);
        (void)hipFuncSetAttribute((const void*)mk_fwd, hipFuncAttributeMaxDynamicSharedMemorySize, LDS_BYTES);
        int dev = 0, cus = 0, per_cu = 0;
        (void)hipGetDevice(&dev); (void)hipDeviceGetAttribute(&cus, hipDeviceAttributeMultiprocessorCount, dev);
        (void)hipOccupancyMaxActiveBlocksPerMultiprocessor(&per_cu, (const void*)mk_fwd, NWAVES * 64, LDS_BYTES);
        if (per_cu < 1) fprintf(stderr, "kernel_launch: occupancy query says %d blocks per CU\n", per_cu);
        (void)hipGetLastError();
        grid = cus > 0 ? cus : 256;
    }
    P p{};
    p.x = (const float*)d_in[0]; p.pos = (const int*)d_in[1]; p.g_mix = (const float*)d_in[2]; p.w_in = (const float*)d_in[3]; p.gn_gain = (const float*)d_in[4];
    p.sgu_gain = (const float*)d_in[5]; p.sgu_w = (const float*)d_in[6]; p.sgu_b = (const float*)d_in[7]; p.w_out = (const float*)d_in[8]; p.g_ffn = (const float*)d_in[9];
    p.w_rg = (const float*)d_in[10]; p.b_rg = (const float*)d_in[11]; p.w_re = (const float*)d_in[12]; p.b_re = (const float*)d_in[13];
    p.w_gu = (const float*)d_in[14]; p.w_up = (const float*)d_in[15]; p.w_dn = (const float*)d_in[16]; p.g_fin = (const float*)d_in[17];
    p.out = (float*)d_out; p.ws = (unsigned char*)d_ws;
    unsigned char* ws = p.ws;
    bf16* PROJ = (bf16*)(ws + WS_PROJ); bf16* KVT = (bf16*)(ws + WS_KVT); bf16* ST = (bf16*)(ws + WS_ST); bf16* MIX = (bf16*)(ws + WS_MIX);
    float* SSQ = (float*)(ws + WS_SSQ); int4* ROUTE = (int4*)(ws + WS_ROUTE); int* CNT = (int*)(ws + WS_CNT); int* ETOK = (int*)(ws + WS_ETOK); float* EW = (float*)(ws + WS_EW);
    int* TILE = (int*)(ws + WS_TILE); float* TMP = (float*)(ws + WS_TMP); bf16* ACT = (bf16*)(ws + WS_ACT); bf16* YE = (bf16*)(ws + WS_YE);
    bf16* H2 = (bf16*)(ws + WS_H);
    (void)ST; (void)SSQ;
    (void)hipMemsetAsync(ws + WS_CTL, 0, CTL_ZERO_BYTES, stream);
#define MK(lo, hi) do { Args a{}; a.p = p; a.ph_lo = (lo); a.ph_hi = (hi); hipLaunchKernelGGL(mk_fwd, dim3(grid), dim3(NWAVES * 64), LDS_BYTES, stream, a); } while (0)
#ifdef DUPL
    MK(0, DUPL + 1); MK(DUPL, DUPL + 1); for (int k_ = DUPL + 1; k_ < 11; ++k_) MK(k_, k_ + 1);
#else
    MK(0, 11);
#endif
    (void)PROJ; (void)KVT; (void)MIX; (void)H2; (void)ROUTE; (void)CNT; (void)TMP; (void)ACT; (void)YE; (void)ETOK; (void)EW; (void)TILE;
#undef MK
}
```

```cpp
#include <hip/hip_runtime.h>
#include <cstdio>
#include <cstdint>

namespace {
constexpr int B_ = 2, S_ = 8192, T_ = B_ * S_, D_ = 1024;
constexpr int RH = 4, DH = 128, CH = 128, NCH = S_ / CH;
constexpr int NIN = 3072;
constexpr int C_Q = 0, C_K = 512, C_V = 1024, C_G = 1536, C_U = 2048, C_VS = 2560;
constexpr int NEXP = 32, FF = 256;
constexpr int MAXENT = 2 * T_ + NEXP * 256;
constexpr int MAXTILES = MAXENT / 256;
constexpr float EPS = 1e-6f;

typedef unsigned short bf16;
typedef float f32x4 __attribute__((ext_vector_type(4)));

constexpr size_t MiB = 1u << 20;
constexpr size_t WS_CTL = 0;
constexpr size_t WS_WIN_T = 1 * MiB, WS_WOUT_T = 7 * MiB, WS_WGU_T = 9 * MiB, WS_WDN_T = 41 * MiB;
constexpr size_t WS_ROUTE = 57 * MiB;
constexpr size_t WS_CNT = 57 * MiB + 256 * 1024;
constexpr size_t WS_ETOK = 57 * MiB + 512 * 1024;
constexpr size_t WS_EW = 57 * MiB + 768 * 1024;
constexpr size_t WS_TOKPOS = 58 * MiB;
constexpr size_t WS_TILE = 58 * MiB + 256 * 1024;
constexpr size_t WS_SSQ = 59 * MiB;
constexpr size_t WS_WSM = 60 * MiB;
constexpr size_t WS_RSTD = 61 * MiB;
constexpr size_t WS_ERS = 61 * MiB + 256 * 1024;
constexpr size_t WS_LP = 224 * MiB;
constexpr size_t WS_X1B = 64 * MiB;
constexpr size_t WS_WRT = 60 * MiB + 512 * 1024;
constexpr size_t WS_H = 64 * MiB;
constexpr size_t WS_ST = 64 * MiB;
constexpr size_t WS_PROJ = 96 * MiB;
constexpr size_t WS_YE = 96 * MiB;
constexpr size_t WS_TMP = 96 * MiB;
constexpr size_t WS_MIX = 192 * MiB;
constexpr size_t WS_ACT = 192 * MiB;
constexpr size_t WS_KVT = 224 * MiB;
constexpr size_t WS_ROPE = 224 * MiB;
constexpr size_t WS_END = 256 * MiB;

struct P {
    const float* x; const int* pos; const float *g_mix, *w_in, *gn_gain, *sgu_gain, *sgu_w, *sgu_b, *w_out, *g_ffn, *w_rg, *b_rg, *w_re, *b_re, *w_gu, *w_up, *w_dn, *g_fin;
    float* out; unsigned char* ws;
};

__device__ __forceinline__ float bf2f(bf16 b) { return __uint_as_float(((unsigned)b) << 16); }
__device__ __forceinline__ bf16 f2bf(float f) { unsigned u = __float_as_uint(f); u += 0x7fffu + ((u >> 16) & 1u); return (bf16)(u >> 16); }
__device__ __forceinline__ unsigned pk2(float lo, float hi) { return (unsigned)f2bf(lo) | ((unsigned)f2bf(hi) << 16); }
__device__ __forceinline__ float wave_sum(float v) {
#pragma unroll
    for (int o = 32; o >= 1; o >>= 1) v += __shfl_xor(v, o);
    return v;
}
__device__ __forceinline__ float silu_f(float v) { return v / (1.0f + __expf(-v)); }
__device__ __forceinline__ float gelu_f(float v) { return 0.5f * v * (1.0f + erff(v * 0.70710678118654752f)); }
__device__ __forceinline__ float log2_gamma(int h) { return log2f(1.0f - exp2f(-5.0f - (float)h)); }
__device__ __forceinline__ float inv_freq(int j) { return powf(10000.0f, -(float)j * (2.0f / 128.0f)); }

__device__ __forceinline__ void ph_rmsnorm_bf16(const float* X, const float* gain, bf16* H, int gw, int ngw, int lane) {
    for (int m = gw; m < T_; m += ngw) {
        const f32x4* xr = (const f32x4*)(X + (size_t)m * D_) + lane;
        f32x4 v[4]; float s = 0.f;
#pragma unroll
        for (int j = 0; j < 4; ++j) { v[j] = xr[64 * j]; s += (v[j].x * v[j].x + v[j].y * v[j].y) + (v[j].z * v[j].z + v[j].w * v[j].w); }
        const float rstd = 1.0f / sqrtf(wave_sum(s) * (1.0f / D_) + EPS);
        unsigned long long* o8 = (unsigned long long*)(H + (size_t)m * D_) + lane;
#pragma unroll
        for (int j = 0; j < 4; ++j) { const f32x4 g = ((const f32x4*)gain)[lane + 64 * j];
            o8[64 * j] = (unsigned long long)pk2(v[j].x * rstd * g.x, v[j].y * rstd * g.y) | ((unsigned long long)pk2(v[j].z * rstd * g.z, v[j].w * rstd * g.w) << 32); }
    }
}

__device__ __forceinline__ void ph_scan(const bf16* KVT, bf16* ST, int gtid, int ngt) {
    for (int item = gtid; item < B_ * RH * 128 * 32; item += ngt) {
        const int d4 = item & 31, e = (item >> 5) & 127, h = (item >> 12) & 3, b = item >> 14;
        const float G = exp2f(128.0f * log2_gamma(h));
        f32x4 s = (f32x4){0.f, 0.f, 0.f, 0.f};
        const size_t nstride = (size_t)RH * 16384;
        const size_t base = ((size_t)(b * NCH) * RH + h) * 16384 + (size_t)e * 128 + d4 * 4;
        for (int n0 = 0; n0 < NCH; n0 += 16) {
            unsigned long long kv[16];
#pragma unroll
            for (int i = 0; i < 16; ++i) kv[i] = *(const unsigned long long*)(KVT + base + (size_t)(n0 + i) * nstride);
#pragma unroll
            for (int i = 0; i < 16; ++i) {
                *(unsigned long long*)(ST + base + (size_t)(n0 + i) * nstride) = (unsigned long long)pk2(s.x, s.y) | ((unsigned long long)pk2(s.z, s.w) << 32);
                const unsigned lo = (unsigned)kv[i], hi = (unsigned)(kv[i] >> 32);
                s = s * G + (f32x4){__uint_as_float(lo << 16), __uint_as_float(lo & 0xffff0000u), __uint_as_float(hi << 16), __uint_as_float(hi & 0xffff0000u)};
            }
        }
    }
}

__device__ __forceinline__ void route_decide(const float (&lg)[4], const float (&le)[4][8], int& e1, int& e2, float& w1, float& w2) {
    int gs = 0; float gm = lg[0];
#pragma unroll
    for (int g = 1; g < 4; ++g) if (lg[g] > gm) { gm = lg[g]; gs = g; }
    float den = 0.f;
#pragma unroll
    for (int g = 0; g < 4; ++g) den += __expf(lg[g] - gm);
    const float gweight = 1.0f / den;
    float sel[8];
#pragma unroll
    for (int e = 0; e < 8; ++e) { sel[e] = le[0][e];
#pragma unroll
        for (int g = 1; g < 4; ++g) sel[e] = (gs == g) ? le[g][e] : sel[e]; }
    int i1 = 0; float v1 = sel[0];
#pragma unroll
    for (int e = 1; e < 8; ++e) if (sel[e] > v1) { v1 = sel[e]; i1 = e; }
    int i2 = (i1 == 0) ? 1 : 0; float v2 = (i1 == 0) ? sel[1] : sel[0];
#pragma unroll
    for (int e = 1; e < 8; ++e) if (e != i1 && sel[e] > v2) { v2 = sel[e]; i2 = e; }
    const float ex = __expf(v2 - v1);
    const float a = 1.0f / (1.0f + ex);
    e1 = gs * 8 + i1; e2 = gs * 8 + i2; w1 = gweight * a; w2 = gweight * ex * a;
}

__device__ __forceinline__ void ph_rank(int4* ROUTE, int* CNT, int gw, int ngw, int lane) {
    for (int c = gw; c < T_ / 64; c += ngw) {
        int4 r = ROUTE[c * 64 + lane];
        const int e1 = r.x & 255, e2 = r.y & 255;
        int r1 = 0, r2 = 0, mycnt = 0;
        const unsigned long long lt = (1ull << lane) - 1ull;
        for (int e = 0; e < NEXP; ++e) {
            const unsigned long long m = __ballot(e1 == e || e2 == e);
            const int below = __popcll(m & lt);
            if (e1 == e) r1 = below;
            if (e2 == e) r2 = below;
            if (lane == e) mycnt = __popcll(m);
        }
        r.x = e1 | (r1 << 8); r.y = e2 | (r2 << 8);
        ROUTE[c * 64 + lane] = r;
        if (lane < NEXP) CNT[c * NEXP + lane] = mycnt;
    }
}

__device__ __forceinline__ void ph_lists(const int4* ROUTE, const int* CNT, const float* RSTD, int* ETOK, float* EW, float* ERS, int2* TOKPOS, int* TILE, int* lds, int bid, int nblk) {
    const int tid = threadIdx.x;
    int* psum = lds;
    int* tot = lds + 512;
    int* off = lds + 544;
    int* base = lds + 576;
    { const int e = tid & 31, part = tid >> 5; int s = 0;
      for (int i = 0; i < 16; ++i) s += CNT[(part * 16 + i) * NEXP + e];
      psum[part * 32 + e] = s; }
    __syncthreads();
    if (tid < 32) { int s = 0; for (int p = 0; p < 16; ++p) s += psum[p * 32 + tid]; tot[tid] = s; }
    __syncthreads();
    if (tid == 0) { int o = 0; for (int e = 0; e < NEXP; ++e) { off[e] = o; o += ((tot[e] + 255) >> 8) << 8; } lds[608] = o >> 8; }
    __syncthreads();
    const int ntiles = lds[608];
    if (bid == 0) {
        if (tid == 0) TILE[0] = ntiles;
        if (tid < NEXP) { const int t0 = off[tid] >> 8, nt = (tot[tid] + 255) >> 8; for (int i = 0; i < nt; ++i) TILE[1 + t0 + i] = tid; }
    }
    for (int e = bid; e < NEXP; e += nblk) {
        const int lo = off[e] + tot[e], hi = off[e] + (((tot[e] + 255) >> 8) << 8);
        for (int p = lo + tid; p < hi; p += blockDim.x) { ETOK[p] = 0; EW[p] = 0.f; ERS[p] = 0.f; }
    }
    for (int c = bid; c < T_ / 64; c += nblk) {
        __syncthreads();
        if (tid < 32) { int s = off[tid]; const int part = c >> 4;
            for (int p = 0; p < part; ++p) s += psum[p * 32 + tid];
            for (int ch = part * 16; ch < c; ++ch) s += CNT[ch * NEXP + tid];
            base[tid] = s; }
        __syncthreads();
        if (tid < 64) { const int t = c * 64 + tid; const int4 r = ROUTE[t];
            const int p1 = base[r.x & 255] + (r.x >> 8), p2 = base[r.y & 255] + (r.y >> 8);
            const float rs = RSTD[t]; ETOK[p1] = t; EW[p1] = __int_as_float(r.z); ERS[p1] = rs; ETOK[p2] = t; EW[p2] = __int_as_float(r.w); ERS[p2] = rs;
            TOKPOS[t] = make_int2(p1, p2); }
    }
}

__device__ __forceinline__ void ph_final(float* out, const bf16* X1B, const bf16* YE, const int2* TOKPOS, const float* gain, int gw, int ngw, int lane) {
    for (int m = gw; m < T_; m += ngw) {
        const int2 pp = TOKPOS[m];
        const unsigned long long* x1 = (const unsigned long long*)(X1B + (size_t)m * D_) + lane;
        const unsigned long long* y1 = (const unsigned long long*)(YE + (size_t)pp.x * D_) + lane;
        const unsigned long long* y2 = (const unsigned long long*)(YE + (size_t)pp.y * D_) + lane;
        f32x4 v[4]; float s = 0.f;
#pragma unroll
        for (int j = 0; j < 4; ++j) {
            const unsigned long long c = x1[64 * j], a = y1[64 * j], b = y2[64 * j];
            v[j].x = bf2f((bf16)(c & 0xffff)) + bf2f((bf16)(a & 0xffff)) + bf2f((bf16)(b & 0xffff));
            v[j].y = bf2f((bf16)((c >> 16) & 0xffff)) + bf2f((bf16)((a >> 16) & 0xffff)) + bf2f((bf16)((b >> 16) & 0xffff));
            v[j].z = bf2f((bf16)((c >> 32) & 0xffff)) + bf2f((bf16)((a >> 32) & 0xffff)) + bf2f((bf16)((b >> 32) & 0xffff));
            v[j].w = bf2f((bf16)(c >> 48)) + bf2f((bf16)(a >> 48)) + bf2f((bf16)(b >> 48));
            s += (v[j].x * v[j].x + v[j].y * v[j].y) + (v[j].z * v[j].z + v[j].w * v[j].w);
        }
        const float rstd = 1.0f / sqrtf(wave_sum(s) * (1.0f / D_) + EPS);
        f32x4* orow = (f32x4*)(out + (size_t)m * D_) + lane;
#pragma unroll
        for (int j = 0; j < 4; ++j) { const f32x4 g = ((const f32x4*)gain)[lane + 64 * j]; orow[64 * j] = v[j] * rstd * g; }
    }
}
__device__ __forceinline__ void ph_route(const float* LP, const float* SSQ, const float* brg, const float* bre, int4* ROUTE, float* RSTD, int* CNT, int gw, int ngw, int lane) {
    for (int c = gw; c < T_ / 64; c += ngw) {
        const int t = c * 64 + lane;
        float ss = 0.f;
        { const f32x4* sp = (const f32x4*)(SSQ + (size_t)t * 16);
#pragma unroll
          for (int i = 0; i < 4; ++i) { const f32x4 v = sp[i]; ss += (v[0] + v[1]) + (v[2] + v[3]); } }
        const float rstd = 1.0f / sqrtf(ss * (1.0f / D_) + EPS);
        RSTD[t] = rstd;
        f32x4 a[9];
        { const f32x4* lp = (const f32x4*)(LP + (size_t)t * 4 * 48);
#pragma unroll
          for (int q = 0; q < 9; ++q) a[q] = (lp[q] + lp[12 + q]) + (lp[24 + q] + lp[36 + q]); }
        float lg[4], le[4][8];
#pragma unroll
        for (int g = 0; g < 4; ++g) { lg[g] = a[8][g] * rstd + brg[g];
#pragma unroll
            for (int e = 0; e < 8; ++e) le[g][e] = a[2 * g + (e >> 2)][e & 3] * rstd + bre[g * 8 + e]; }
        int e1, e2; float w1, w2; route_decide(lg, le, e1, e2, w1, w2);
        int r1 = 0, r2 = 0, mycnt = 0;
        const unsigned long long lt = (1ull << lane) - 1ull;
        for (int e = 0; e < NEXP; ++e) {
            const unsigned long long mk = __ballot(e1 == e || e2 == e);
            const int below = __popcll(mk & lt);
            if (e1 == e) r1 = below;
            if (e2 == e) r2 = below;
            if (lane == e) mycnt = __popcll(mk);
        }
        ROUTE[t] = make_int4(e1 | (r1 << 8), e2 | (r2 << 8), __float_as_int(w1), __float_as_int(w2));
        if (lane < NEXP) CNT[c * NEXP + lane] = mycnt;
    }
}
}
#define LAS __attribute__((address_space(3)))
namespace pg8 {
#define PG8_LAS __attribute__((address_space(3)))
typedef unsigned short bf16_t;
typedef short bf16x8 __attribute__((ext_vector_type(8)));
typedef float f32x4 __attribute__((ext_vector_type(4)));
typedef unsigned u32x4 __attribute__((ext_vector_type(4)));
constexpr int BM = 256, BK = 64, HALF = 128, HTB = HALF * BK * 2  , STAGE_BYTES = 8 * HTB, NXCD = 8, WGM = 8;

__host__ __device__ __forceinline__ int lds_byte(int r, int c) { const int st = (r >> 4) * 2 + (c >> 5), rr = r & 15, cc = c & 31, ob = rr * 64 + cc * 2; return st * 1024 + (ob ^ (((ob >> 9) & 1) << 5)); }
__host__ __device__ __forceinline__ void stage_rc(int b, int& R, int& C) { const int st = b / 1024, sb = b % 1024, swz = sb ^ (((sb >> 9) & 1) << 5); R = (st >> 1) * 16 + swz / 64; C = (st & 1) * 32 + (swz % 64) / 2; }
__host__ __device__ __forceinline__ int perm32(int rho) { const int n = rho >> 4, i = rho & 15; return 8 * (i >> 2) + 4 * n + (i & 3); }

struct Unit { int pm, pn; };
struct Gemm { const bf16_t* A; const bf16_t* Bt; int M, N, K; };

struct StaticOrder {
    int nM, nN, nwg, G, c;
    __host__ __device__ void init(int M, int N, int G_, int c_) { nM = M / BM; nN = N / BM; nwg = nM * nN; G = G_; c = c_; }
    __host__ __device__ bool next(int i, Unit& u) const {
        const long L = (long)i * G + c; if (L >= nwg) return false;
        int wgid = (int)L; { const int q = nwg / NXCD, r = nwg % NXCD, xcd = wgid % NXCD, off = wgid / NXCD; wgid = (xcd < r ? xcd * (q + 1) : r * (q + 1) + (xcd - r) * q) + off; }
        const int nig = WGM * nN, gid = wgid / nig, fm = gid * WGM, gsz = (nM - fm) < WGM ? (nM - fm) : WGM;
        u.pm = fm + ((wgid % nig) % gsz); u.pn = (wgid % nig) / gsz; return true;
    }
    __device__ __forceinline__ void a_ready(const Unit&) const {}
    __device__ __forceinline__ void done(const Unit&) const {}
};
typedef float cvt_f32x2 __attribute__((ext_vector_type(2))); typedef __bf16 cvt_bf16x2 __attribute__((ext_vector_type(2)));
__device__ __forceinline__ unsigned cvt_pk_bf16(float lo, float hi) { const cvt_f32x2 v = {lo, hi}; return __builtin_bit_cast(unsigned, __builtin_convertvector(v, cvt_bf16x2)); }
typedef float f32x2 __attribute__((ext_vector_type(2)));
__device__ __forceinline__ f32x2 gelu_pk(f32x2 v) {
    const f32x2 av = __builtin_elementwise_abs(v), d = av * 0.2316418882f + 1.0f;
    f32x2 t; t.x = __builtin_amdgcn_rcpf(d.x); t.y = __builtin_amdgcn_rcpf(d.y);
    f32x2 q = t * 0.5307027145f + (-0.7265760135f); q = q * t + 0.7107068705f; q = q * t + (-0.142248368f); q = q * t + 0.127414796f; q = q * t;
    const f32x2 s = (v * v) * (-0.72134752044f);
    f32x2 e; e.x = __builtin_amdgcn_exp2f(s.x); e.y = __builtin_amdgcn_exp2f(s.y);
    const f32x2 m = v * (q * e), r = v - m;
    f32x2 o; o.x = v.x < 0.f ? m.x : r.x; o.y = v.y < 0.f ? m.y : r.y; return o;
}
template <class Epi, class Sched, bool ALIGN_EPI = false, bool SP2 = false>
__device__ __forceinline__ void gemm_phase(PG8_LAS unsigned char* lds, const Gemm g, const Sched& S, const Epi& E) {
    const int tid = threadIdx.x, wid = __builtin_amdgcn_readfirstlane(tid >> 6), lane = tid & 63, wr = wid >> 2, wc = wid & 3, fr = lane & 15, fq = lane >> 4;
    const int K = g.K, nt = K / BK;
    unsigned voffA[2], voffB[2];
#pragma unroll
    for (int i = 0; i < 2; ++i) { int R, C; stage_rc(tid * 16 + i * 8192, R, C); const int Rb = Epi::PERM ? ((R & ~31) + perm32(R & 31)) : R;
        voffA[i] = (unsigned)(R * K + C) * 2u; voffB[i] = (unsigned)(Rb * K + C) * 2u; }
    const size_t kstep = (size_t)(BK * 2);
    const size_t hstep = (size_t)HALF * K * 2;
    const size_t tstep = 2 * hstep;
    const unsigned ldsw = (unsigned)wid * 1024u;
    const int aoff = lds_byte(wr * 64 + fr, fq * 8), boff = lds_byte(wc * 32 + fr, fq * 8);
#define PG8_SA(b, h) (((b) * 2 + (h)) * HTB)
#define PG8_SB(b, h) ((4 + (b) * 2 + (h)) * HTB)
#define PG8_STAGE(bufoff, gbase, voff) do { _Pragma("unroll") for (int _i = 0; _i < 2; ++_i) \
        __builtin_amdgcn_global_load_lds((const unsigned*)((const char*)(gbase) + (voff)[_i]), (PG8_LAS unsigned*)(lds + (bufoff) + ldsw + _i * 8192), 16, 0, 0); } while (0)
#define PG8_LDA(dst, b, h) do { _Pragma("unroll") for (int m = 0; m < 4; ++m) _Pragma("unroll") for (int k = 0; k < 2; ++k) dst[m][k] = *(const PG8_LAS bf16x8*)(lds + PG8_SA(b, h) + aoff + m * 2048 + k * 1024); } while (0)
#define PG8_LDB(dst, b, h) do { _Pragma("unroll") for (int n = 0; n < 2; ++n) _Pragma("unroll") for (int k = 0; k < 2; ++k) dst[n][k] = *(const PG8_LAS bf16x8*)(lds + PG8_SB(b, h) + boff + n * 2048 + k * 1024); } while (0)
#define PG8_MMA(ai, bj, At, Bt) do { __builtin_amdgcn_s_setprio(1); _Pragma("unroll") for (int m = 0; m < 4; ++m) _Pragma("unroll") for (int n = 0; n < 2; ++n) _Pragma("unroll") for (int k = 0; k < 2; ++k) \
        acc[ai][bj][m][n] = __builtin_amdgcn_mfma_f32_16x16x32_bf16(Bt[n][k], At[m][k], acc[ai][bj][m][n], 0, 0, 0); __builtin_amdgcn_s_setprio(0); } while (0)
#define PG8_WAIT_V(n) asm volatile("s_waitcnt vmcnt(" #n ")" ::: "memory")
#define PG8_WAIT_L(n) asm volatile("s_waitcnt lgkmcnt(" #n ")" ::: "memory")
#define PG8_BAR __builtin_amdgcn_s_barrier()
#define PG8_SCHED __builtin_amdgcn_sched_barrier(0)
    Unit cur, nxt; int ui = 0;
    if (!S.next(0, cur)) return;
    f32x4 acc[2][2][4][2];
#pragma unroll
    for (int a = 0; a < 2; ++a)
#pragma unroll
        for (int b = 0; b < 2; ++b)
#pragma unroll
            for (int m = 0; m < 4; ++m)
#pragma unroll
                for (int n = 0; n < 2; ++n) acc[a][b][m][n] = (f32x4){0.f, 0.f, 0.f, 0.f};
    bf16x8 At[4][2], B0[2][2], B1[2][2];
    const char* cA = (const char*)g.A + (size_t)cur.pm * tstep; const char* cB = (const char*)g.Bt + (size_t)cur.pn * tstep;
    S.a_ready(cur);
    if constexpr (SP2) {
        PG8_STAGE(PG8_SB(0, 0), cB, voffB); PG8_STAGE(PG8_SB(0, 1), cB + hstep, voffB); PG8_STAGE(PG8_SA(0, 0), cA, voffA); PG8_STAGE(PG8_SA(0, 1), cA + hstep, voffA);
        if (wr == 1) PG8_BAR;
        PG8_WAIT_V(2); PG8_BAR;
        PG8_STAGE(PG8_SB(1, 0), cB + kstep, voffB); PG8_STAGE(PG8_SA(1, 0), cA + kstep, voffA); PG8_STAGE(PG8_SB(1, 1), cB + hstep + kstep, voffB);
        PG8_WAIT_V(6); PG8_BAR;
    } else {
        PG8_STAGE(PG8_SB(0, 0), cB, voffB); PG8_STAGE(PG8_SA(0, 0), cA, voffA); PG8_STAGE(PG8_SB(0, 1), cB + hstep, voffB); PG8_STAGE(PG8_SA(0, 1), cA + hstep, voffA);
        if (wr == 1) PG8_BAR;
        PG8_WAIT_V(4); PG8_BAR;
        PG8_STAGE(PG8_SB(1, 0), cB + kstep, voffB); PG8_STAGE(PG8_SA(1, 0), cA + kstep, voffA); PG8_STAGE(PG8_SB(1, 1), cB + hstep + kstep, voffB);
        PG8_WAIT_V(6); PG8_BAR;
    }
    for (;;) {
        const bool has_next = S.next(ui + 1, nxt);
        const char* nA = has_next ? (const char*)g.A + (size_t)nxt.pm * tstep : cA; const char* nB = has_next ? (const char*)g.Bt + (size_t)nxt.pn * tstep : cB;
        for (int t = 0; t < nt; t += 2) {
            const bool last = (t == nt - 2);
            const char* a1 = cA + (size_t)(t + 1) * kstep;
            const char* a2 = last ? nA : cA + (size_t)(t + 2) * kstep; const char* b2 = last ? nB : cB + (size_t)(t + 2) * kstep;
            const char* a3 = a2 + kstep; const char* b3 = b2 + kstep;
            if (last && has_next) S.a_ready(nxt);
            if constexpr (SP2) {
            PG8_LDB(B0, 0, 0); PG8_LDB(B1, 0, 1); PG8_SCHED; PG8_LDA(At, 0, 0); PG8_STAGE(PG8_SA(1, 1), a1 + hstep, voffA);
            PG8_WAIT_V(8); PG8_WAIT_L(0); PG8_BAR; PG8_MMA(0, 0, At, B0); PG8_MMA(0, 1, At, B1); PG8_BAR; PG8_SCHED;
            PG8_LDA(At, 0, 1); PG8_STAGE(PG8_SB(0, 0), b2, voffB); PG8_STAGE(PG8_SB(0, 1), b2 + hstep, voffB); PG8_STAGE(PG8_SA(0, 0), a2, voffA);
            PG8_WAIT_V(8); PG8_WAIT_L(0); PG8_BAR; PG8_MMA(1, 0, At, B0); PG8_MMA(1, 1, At, B1); PG8_BAR; PG8_SCHED;
            PG8_LDB(B0, 1, 0); PG8_LDB(B1, 1, 1); PG8_SCHED; PG8_LDA(At, 1, 0); PG8_STAGE(PG8_SA(0, 1), a2 + hstep, voffA);
            PG8_WAIT_V(8); PG8_WAIT_L(0); PG8_BAR; PG8_MMA(0, 0, At, B0); PG8_MMA(0, 1, At, B1); PG8_BAR; PG8_SCHED;
            PG8_LDA(At, 1, 1); PG8_STAGE(PG8_SB(1, 0), b3, voffB); PG8_STAGE(PG8_SB(1, 1), b3 + hstep, voffB); PG8_STAGE(PG8_SA(1, 0), a3, voffA);
            PG8_WAIT_V(8); PG8_WAIT_L(0); PG8_BAR; PG8_MMA(1, 0, At, B0); PG8_MMA(1, 1, At, B1); PG8_BAR; PG8_SCHED;
            } else {
            PG8_LDB(B0, 0, 0); PG8_SCHED; PG8_LDA(At, 0, 0); PG8_STAGE(PG8_SA(1, 1), a1 + hstep, voffA);
            PG8_WAIT_L(8); PG8_BAR; PG8_WAIT_L(0); PG8_MMA(0, 0, At, B0); PG8_BAR; PG8_SCHED;
            PG8_LDB(B1, 0, 1); PG8_STAGE(PG8_SB(0, 0), b2, voffB);
            PG8_BAR; PG8_WAIT_L(0); PG8_MMA(0, 1, At, B1); PG8_BAR;
            PG8_LDA(At, 0, 1); PG8_STAGE(PG8_SA(0, 0), a2, voffA);
            PG8_BAR; PG8_WAIT_L(0); PG8_MMA(1, 0, At, B0); PG8_BAR; PG8_SCHED;
            PG8_STAGE(PG8_SB(0, 1), b2 + hstep, voffB);
            PG8_WAIT_V(6); PG8_BAR; PG8_MMA(1, 1, At, B1); PG8_BAR;
            PG8_LDB(B0, 1, 0); PG8_SCHED; PG8_LDA(At, 1, 0); PG8_STAGE(PG8_SA(0, 1), a2 + hstep, voffA);
            PG8_WAIT_L(8); PG8_BAR; PG8_WAIT_L(0); PG8_MMA(0, 0, At, B0); PG8_BAR; PG8_SCHED;
            PG8_LDB(B1, 1, 1); PG8_STAGE(PG8_SB(1, 0), b3, voffB);
            PG8_BAR; PG8_WAIT_L(0); PG8_MMA(0, 1, At, B1); PG8_BAR;
            PG8_LDA(At, 1, 1); PG8_STAGE(PG8_SA(1, 0), a3, voffA);
            PG8_BAR; PG8_WAIT_L(0); PG8_MMA(1, 0, At, B0); PG8_BAR; PG8_SCHED;
            PG8_STAGE(PG8_SB(1, 1), b3 + hstep, voffB);
            PG8_WAIT_V(6); PG8_BAR; PG8_MMA(1, 1, At, B1); PG8_BAR;
            }
        }
        if constexpr (ALIGN_EPI) { if (wr == 0) PG8_BAR; }
        if constexpr (!Epi::AFTER_DRAIN) { E(acc, cur, wr, wc, fr, fq); S.done(cur); }
        if (!has_next) break;
#pragma unroll
        for (int a = 0; a < 2; ++a)
#pragma unroll
            for (int b = 0; b < 2; ++b)
#pragma unroll
                for (int m = 0; m < 4; ++m)
#pragma unroll
                    for (int n = 0; n < 2; ++n) acc[a][b][m][n] = (f32x4){0.f, 0.f, 0.f, 0.f};
        cur = nxt; cA = nA; cB = nB; ++ui;
        if constexpr (ALIGN_EPI) { if (wr == 1) PG8_BAR; }
    }
    PG8_WAIT_V(0);
    if constexpr (!ALIGN_EPI) { if (wr == 0) PG8_BAR; }
    PG8_BAR;
    if constexpr (Epi::AFTER_DRAIN) { E.fused(acc, cur, wr, wc, fr, fq, lds, wid, lane); S.done(cur); }
#undef PG8_SA
#undef PG8_SB
#undef PG8_STAGE
#undef PG8_LDA
#undef PG8_LDB
#undef PG8_MMA
#undef PG8_WAIT_V
#undef PG8_WAIT_L
#undef PG8_BAR
#undef PG8_SCHED
}
}
namespace pg8 {
typedef unsigned u32x2 __attribute__((ext_vector_type(2)));
__device__ __forceinline__ f32x4 silu4(f32x4 v) {
    f32x4 o;
#pragma unroll
    for (int j = 0; j < 4; ++j) o[j] = v[j] * __builtin_amdgcn_rcpf(1.0f + __builtin_amdgcn_exp2f(-1.44269504089f * v[j]));
    return o;
}
struct EpiProj {
    static constexpr bool PERM = true, AFTER_DRAIN = false;
    bf16_t* O; const float* COS; const float* SIN;
    __device__ __forceinline__ void operator()(const f32x4 (&acc)[2][2][4][2], const Unit& u, int wr, int wc, int fr, int fq) const {
        const int row0 = u.pm * BM + wr * 64 + fr; const int seg = u.pn >> 1;
        if (seg <= 1) {
            const float sc = seg == 1 ? 0.08838834764831845f : 1.0f;
#pragma unroll
            for (int ai = 0; ai < 2; ++ai)
#pragma unroll
                for (int m = 0; m < 4; ++m) { const int r = row0 + ai * HALF + m * 16;
                    const f32x4 cs = *(const f32x4*)(COS + (size_t)r * 64 + 16 * wc + 4 * fq) * sc, sn = *(const f32x4*)(SIN + (size_t)r * 64 + 16 * wc + 4 * fq) * sc;
                    bf16_t* rowp = O + ((size_t)(seg * 4 + 2 * (u.pn & 1)) * 16384 + r) * 128 + 16 * wc + 4 * fq;
#pragma unroll
                    for (int bj = 0; bj < 2; ++bj) { const f32x4 x1 = acc[ai][bj][m][0], x2 = acc[ai][bj][m][1];
                        const f32x4 y1 = x1 * cs - x2 * sn, y2 = x1 * sn + x2 * cs;
                        u32x2 w1, w2; w1.x = cvt_pk_bf16(y1[0], y1[1]); w1.y = cvt_pk_bf16(y1[2], y1[3]); w2.x = cvt_pk_bf16(y2[0], y2[1]); w2.y = cvt_pk_bf16(y2[2], y2[3]);
                        *(u32x2*)(rowp + (size_t)bj * 16384 * 128) = w1; *(u32x2*)(rowp + (size_t)bj * 16384 * 128 + 64) = w2; } }
        } else {
#pragma unroll
            for (int ai = 0; ai < 2; ++ai)
#pragma unroll
                for (int m = 0; m < 4; ++m) { bf16_t* rowp = O + ((size_t)(seg * 4 + 2 * (u.pn & 1)) * 16384 + row0 + ai * HALF + m * 16) * 128 + wc * 32 + 8 * fq;
#pragma unroll
                    for (int bj = 0; bj < 2; ++bj) { f32x4 v0 = acc[ai][bj][m][0], v1 = acc[ai][bj][m][1];
                        if (seg == 3) { v0 = silu4(v0); v1 = silu4(v1); }
                        if (seg >= 4) { f32x2 a = gelu_pk((f32x2){v0[0], v0[1]}), b = gelu_pk((f32x2){v0[2], v0[3]}), c = gelu_pk((f32x2){v1[0], v1[1]}), d = gelu_pk((f32x2){v1[2], v1[3]});
                            v0 = (f32x4){a.x, a.y, b.x, b.y}; v1 = (f32x4){c.x, c.y, d.x, d.y}; }
                        u32x4 w; w.x = cvt_pk_bf16(v0[0], v0[1]); w.y = cvt_pk_bf16(v0[2], v0[3]); w.z = cvt_pk_bf16(v1[0], v1[1]); w.w = cvt_pk_bf16(v1[2], v1[3]);
                        *(u32x4*)(rowp + (size_t)bj * 16384 * 128) = w; } }
        }
    }
};
struct EpiRes2 {
    static constexpr bool PERM = true, AFTER_DRAIN = false;
    const float* X; bf16_t* X1B; float* SSQ; const bf16_t* WRT; float* LP; PG8_LAS float* slots;
    __device__ __forceinline__ void operator()(const f32x4 (&acc)[2][2][4][2], const Unit& u, int wr, int wc, int fr, int fq) const {
        const int tid = threadIdx.x;
        const int row0 = u.pm * BM + wr * 64 + fr, colb = u.pn * BM + wc * 32 + 8 * fq;
#pragma unroll
        for (int ai = 0; ai < 2; ++ai)
#pragma unroll
            for (int m = 0; m < 4; ++m) { const int r = row0 + ai * HALF + m * 16; const size_t off = (size_t)r * 1024 + colb; float ss = 0.f;
                f32x4 lg[3];
#pragma unroll
                for (int nt = 0; nt < 3; ++nt) lg[nt] = (f32x4){0.f, 0.f, 0.f, 0.f};
#pragma unroll
                for (int bj = 0; bj < 2; ++bj) {
                    int z = 0; asm volatile("" : "+v"(z));
                    const bf16_t* wp = WRT + (size_t)fr * 1024 + colb + bj * HALF + z;
                    bf16x8 Bh[3], Bl[3];
#pragma unroll
                    for (int nt = 0; nt < 3; ++nt) { Bh[nt] = *(const bf16x8*)(wp + (size_t)(16 * nt) * 1024); Bl[nt] = *(const bf16x8*)(wp + (size_t)(48 + 16 * nt) * 1024); }
                    const f32x4 o0 = *(const f32x4*)(X + off + bj * HALF) + acc[ai][bj][m][0], o1 = *(const f32x4*)(X + off + bj * HALF + 4) + acc[ai][bj][m][1];
                    ss += ((o0[0] * o0[0] + o0[1] * o0[1]) + (o0[2] * o0[2] + o0[3] * o0[3])) + ((o1[0] * o1[0] + o1[1] * o1[1]) + (o1[2] * o1[2] + o1[3] * o1[3]));
                    u32x4 h, l;
                    h.x = cvt_pk_bf16(o0[0], o0[1]); h.y = cvt_pk_bf16(o0[2], o0[3]); h.z = cvt_pk_bf16(o1[0], o1[1]); h.w = cvt_pk_bf16(o1[2], o1[3]);
                    *(u32x4*)(X1B + off + bj * HALF) = h;
                    l.x = cvt_pk_bf16(o0[0] - __uint_as_float(h.x << 16), o0[1] - __uint_as_float(h.x & 0xffff0000u));
                    l.y = cvt_pk_bf16(o0[2] - __uint_as_float(h.y << 16), o0[3] - __uint_as_float(h.y & 0xffff0000u));
                    l.z = cvt_pk_bf16(o1[0] - __uint_as_float(h.z << 16), o1[1] - __uint_as_float(h.z & 0xffff0000u));
                    l.w = cvt_pk_bf16(o1[2] - __uint_as_float(h.w << 16), o1[3] - __uint_as_float(h.w & 0xffff0000u));
                    const bf16x8 ah = __builtin_bit_cast(bf16x8, h), al = __builtin_bit_cast(bf16x8, l);
#pragma unroll
                    for (int nt = 0; nt < 3; ++nt) {
                        lg[nt] = __builtin_amdgcn_mfma_f32_16x16x32_bf16(Bh[nt], ah, lg[nt], 0, 0, 0);
                        lg[nt] = __builtin_amdgcn_mfma_f32_16x16x32_bf16(Bh[nt], al, lg[nt], 0, 0, 0);
                        lg[nt] = __builtin_amdgcn_mfma_f32_16x16x32_bf16(Bl[nt], ah, lg[nt], 0, 0, 0);
                    }
                }
                ss += __shfl_xor(ss, 16); ss += __shfl_xor(ss, 32);
                if (fq == 0) SSQ[(size_t)r * 16 + u.pn * 4 + wc] = ss;
#pragma unroll
                for (int nt = 0; nt < 3; ++nt) *(PG8_LAS f32x4*)(slots + (wc * 32 + wr * 16 + fr) * 48 + 16 * nt + 4 * fq) = lg[nt];
                asm volatile("s_waitcnt lgkmcnt(0)" ::: "memory"); __builtin_amdgcn_s_barrier(); asm volatile("" ::: "memory");
                if (tid < 384) { const int rl = tid / 12, q = tid - rl * 12;
                    const f32x4 sv = (*(const PG8_LAS f32x4*)(slots + (0 * 32 + rl) * 48 + 4 * q) + *(const PG8_LAS f32x4*)(slots + (1 * 32 + rl) * 48 + 4 * q))
                                   + (*(const PG8_LAS f32x4*)(slots + (2 * 32 + rl) * 48 + 4 * q) + *(const PG8_LAS f32x4*)(slots + (3 * 32 + rl) * 48 + 4 * q));
                    const int grow = u.pm * BM + ai * HALF + (rl >> 4) * 64 + m * 16 + (rl & 15);
                    *(f32x4*)(LP + ((size_t)grow * 4 + u.pn) * 48 + 4 * q) = sv; }
                asm volatile("s_waitcnt lgkmcnt(0)" ::: "memory"); __builtin_amdgcn_s_barrier(); asm volatile("" ::: "memory");
            }
    }
};
}
namespace pg8 {
struct UnitG : Unit { const char* aB; const char* bB; };
template <class Epi, class Sched>
__device__ __forceinline__ void gemm_phase_g(PG8_LAS unsigned char* lds, const int K, const Sched& S, const Epi& E) {
    const int tid = threadIdx.x, wid = __builtin_amdgcn_readfirstlane(tid >> 6), lane = tid & 63, wr = wid >> 2, wc = wid & 3, fr = lane & 15, fq = lane >> 4;
    const int nt = K / BK;
    unsigned voffB[2];
#pragma unroll
    for (int i = 0; i < 2; ++i) { int R, C; stage_rc(tid * 16 + i * 8192, R, C); const int Rb = Epi::PERM ? ((R & ~31) + perm32(R & 31)) : R;
        voffB[i] = (unsigned)(Rb * K + C) * 2u; }
    const size_t kstep = (size_t)(BK * 2);
    const size_t hstep = (size_t)HALF * K * 2;
    const unsigned ldsw = (unsigned)wid * 1024u;
    const int aoff = lds_byte(wr * 64 + fr, fq * 8), boff = lds_byte(wc * 32 + fr, fq * 8);
#define PG8_SA(b, h) (((b) * 2 + (h)) * HTB)
#define PG8_SB(b, h) ((4 + (b) * 2 + (h)) * HTB)
#define PG8_STAGE(bufoff, gbase, voff) do { _Pragma("unroll") for (int _i = 0; _i < 2; ++_i) \
        __builtin_amdgcn_global_load_lds((const unsigned*)((const char*)(gbase) + (voff)[_i]), (PG8_LAS unsigned*)(lds + (bufoff) + ldsw + _i * 8192), 16, 0, 0); } while (0)
#define PG8_LDA(dst, b, h) do { _Pragma("unroll") for (int m = 0; m < 4; ++m) _Pragma("unroll") for (int k = 0; k < 2; ++k) dst[m][k] = *(const PG8_LAS bf16x8*)(lds + PG8_SA(b, h) + aoff + m * 2048 + k * 1024); } while (0)
#define PG8_LDB(dst, b, h) do { _Pragma("unroll") for (int n = 0; n < 2; ++n) _Pragma("unroll") for (int k = 0; k < 2; ++k) dst[n][k] = *(const PG8_LAS bf16x8*)(lds + PG8_SB(b, h) + boff + n * 2048 + k * 1024); } while (0)
#define PG8_MMA(ai, bj, At, Bt) do { __builtin_amdgcn_s_setprio(1); _Pragma("unroll") for (int m = 0; m < 4; ++m) _Pragma("unroll") for (int n = 0; n < 2; ++n) _Pragma("unroll") for (int k = 0; k < 2; ++k) \
        acc[ai][bj][m][n] = __builtin_amdgcn_mfma_f32_16x16x32_bf16(Bt[n][k], At[m][k], acc[ai][bj][m][n], 0, 0, 0); __builtin_amdgcn_s_setprio(0); } while (0)
#define PG8_WAIT_V(n) asm volatile("s_waitcnt vmcnt(" #n ")" ::: "memory")
#define PG8_WAIT_L(n) asm volatile("s_waitcnt lgkmcnt(" #n ")" ::: "memory")
#define PG8_BAR __builtin_amdgcn_s_barrier()
#define PG8_SCHED __builtin_amdgcn_sched_barrier(0)
    UnitG cur, nxt; int ui = 0;
    if (!S.next(0, cur)) return;
    f32x4 acc[2][2][4][2];
#pragma unroll
    for (int a = 0; a < 2; ++a)
#pragma unroll
        for (int b = 0; b < 2; ++b)
#pragma unroll
            for (int m = 0; m < 4; ++m)
#pragma unroll
                for (int n = 0; n < 2; ++n) acc[a][b][m][n] = (f32x4){0.f, 0.f, 0.f, 0.f};
    bf16x8 At[4][2], B0[2][2], B1[2][2];
    unsigned curA[2][2], nxtA[2][2];
    S.a_offs(cur, tid, curA);
    const char* cA = cur.aB; const char* cB = cur.bB;
    PG8_STAGE(PG8_SB(0, 0), cB, voffB); PG8_STAGE(PG8_SB(0, 1), cB + hstep, voffB); PG8_STAGE(PG8_SA(0, 0), cA, curA[0]); PG8_STAGE(PG8_SA(0, 1), cA, curA[1]);
    if (wr == 1) PG8_BAR;
    PG8_WAIT_V(2); PG8_BAR;
    PG8_STAGE(PG8_SB(1, 0), cB + kstep, voffB); PG8_STAGE(PG8_SA(1, 0), cA + kstep, curA[0]); PG8_STAGE(PG8_SB(1, 1), cB + hstep + kstep, voffB);
    PG8_WAIT_V(6); PG8_BAR;
    for (;;) {
        const bool has_next = S.next(ui + 1, nxt);
        if (has_next) S.a_offs(nxt, tid, nxtA);
        else {
#pragma unroll
            for (int h = 0; h < 2; ++h)
#pragma unroll
                for (int i = 0; i < 2; ++i) nxtA[h][i] = curA[h][i]; }
        const char* nA = has_next ? nxt.aB : cA; const char* nB = has_next ? nxt.bB : cB;
#pragma unroll 1
        for (int t = 0; t < nt; t += 2) {
            const bool last = (t == nt - 2);
            const char* a1 = cA + (size_t)(t + 1) * kstep;
            const char* a2 = last ? nA : cA + (size_t)(t + 2) * kstep; const char* b2 = last ? nB : cB + (size_t)(t + 2) * kstep;
            const char* a3 = a2 + kstep; const char* b3 = b2 + kstep;
            unsigned oa2[2][2];
#pragma unroll
            for (int h = 0; h < 2; ++h)
#pragma unroll
                for (int i = 0; i < 2; ++i) oa2[h][i] = last ? nxtA[h][i] : curA[h][i];
            PG8_LDB(B0, 0, 0); PG8_LDB(B1, 0, 1); PG8_SCHED; PG8_LDA(At, 0, 0); PG8_STAGE(PG8_SA(1, 1), a1, curA[1]);
            PG8_WAIT_V(8); PG8_WAIT_L(0); PG8_BAR; PG8_MMA(0, 0, At, B0); PG8_MMA(0, 1, At, B1); PG8_BAR; PG8_SCHED;
            PG8_LDA(At, 0, 1); PG8_STAGE(PG8_SB(0, 0), b2, voffB); PG8_STAGE(PG8_SB(0, 1), b2 + hstep, voffB); PG8_STAGE(PG8_SA(0, 0), a2, oa2[0]);
            PG8_WAIT_V(8); PG8_WAIT_L(0); PG8_BAR; PG8_MMA(1, 0, At, B0); PG8_MMA(1, 1, At, B1); PG8_BAR; PG8_SCHED;
            PG8_LDB(B0, 1, 0); PG8_LDB(B1, 1, 1); PG8_SCHED; PG8_LDA(At, 1, 0); PG8_STAGE(PG8_SA(0, 1), a2, oa2[1]);
            PG8_WAIT_V(8); PG8_WAIT_L(0); PG8_BAR; PG8_MMA(0, 0, At, B0); PG8_MMA(0, 1, At, B1); PG8_BAR; PG8_SCHED;
            PG8_LDA(At, 1, 1); PG8_STAGE(PG8_SB(1, 0), b3, voffB); PG8_STAGE(PG8_SB(1, 1), b3 + hstep, voffB); PG8_STAGE(PG8_SA(1, 0), a3, oa2[0]);
            PG8_WAIT_V(8); PG8_WAIT_L(0); PG8_BAR; PG8_MMA(1, 0, At, B0); PG8_MMA(1, 1, At, B1); PG8_BAR; PG8_SCHED;
        }
        if (wr == 0) PG8_BAR;
        E(acc, cur, wr, wc, fr, fq);
        if (!has_next) break;
#pragma unroll
        for (int a = 0; a < 2; ++a)
#pragma unroll
            for (int b = 0; b < 2; ++b)
#pragma unroll
                for (int m = 0; m < 4; ++m)
#pragma unroll
                    for (int n = 0; n < 2; ++n) acc[a][b][m][n] = (f32x4){0.f, 0.f, 0.f, 0.f};
        cur = nxt; cA = nA; cB = nB; ++ui;
#pragma unroll
        for (int h = 0; h < 2; ++h)
#pragma unroll
            for (int i = 0; i < 2; ++i) curA[h][i] = nxtA[h][i];
        if (wr == 1) PG8_BAR;
    }
    PG8_WAIT_V(0);
    PG8_BAR;
#undef PG8_SA
#undef PG8_SB
#undef PG8_STAGE
#undef PG8_LDA
#undef PG8_LDB
#undef PG8_MMA
#undef PG8_WAIT_V
#undef PG8_WAIT_L
#undef PG8_BAR
#undef PG8_SCHED
}

struct MoeASched {
    const int* TILE; const int* ETOK; const char* H2; const char* WGU; int G, c;
    __device__ __forceinline__ bool next(int i, UnitG& u) const {
        const int L = i * G + c, nt = TILE[0]; if (L >= nt * 2) return false;
        const int ti = L >> 1, pn = L & 1, e = TILE[1 + ti];
        u.pm = ti; u.pn = pn; u.aB = H2; u.bB = WGU + ((size_t)e * 512 + pn * 256) * 2048; return true; }
    __device__ __forceinline__ void a_offs(const UnitG& u, int tid, unsigned (&o)[2][2]) const {
#pragma unroll
        for (int i = 0; i < 2; ++i) { int R, C; stage_rc(tid * 16 + i * 8192, R, C);
#pragma unroll
            for (int h = 0; h < 2; ++h) o[h][i] = (unsigned)ETOK[u.pm * 256 + h * 128 + R] * 2048u + (unsigned)C * 2u; } }
};
struct MoeBSched {
    const int* TILE; const char* ACT; const char* WDN; int G, c;
    __device__ __forceinline__ bool next(int i, UnitG& u) const {
        const int L = i * G + c, nt = TILE[0]; if (L >= nt * 4) return false;
        const int ti = L >> 2, pn = L & 3, e = TILE[1 + ti];
        u.pm = ti; u.pn = pn; u.aB = ACT + (size_t)ti * 256 * 512; u.bB = WDN + ((size_t)e * 1024 + pn * 256) * 512; return true; }
    __device__ __forceinline__ void a_offs(const UnitG&, int tid, unsigned (&o)[2][2]) const {
#pragma unroll
        for (int i = 0; i < 2; ++i) { int R, C; stage_rc(tid * 16 + i * 8192, R, C);
#pragma unroll
            for (int h = 0; h < 2; ++h) o[h][i] = (unsigned)((h * 128 + R) * 256 + C) * 2u; } }
};
struct EpiAct {
    static constexpr bool PERM = true, AFTER_DRAIN = false;
    bf16_t* ACT; const float* EW; const float* ERS;
    __device__ __forceinline__ void operator()(const f32x4 (&acc)[2][2][4][2], const UnitG& u, int wr, int wc, int fr, int fq) const {
        const int row0 = u.pm * BM + wr * 64 + fr;
#pragma unroll
        for (int ai = 0; ai < 2; ++ai)
#pragma unroll
            for (int m = 0; m < 4; ++m) { const int r = row0 + ai * HALF + m * 16; const float rs = ERS[r], w = EW[r] * rs;
                const f32x4 v0 = silu4(acc[ai][0][m][0] * rs) * acc[ai][1][m][0] * w, v1 = silu4(acc[ai][0][m][1] * rs) * acc[ai][1][m][1] * w;
                u32x4 o; o.x = cvt_pk_bf16(v0[0], v0[1]); o.y = cvt_pk_bf16(v0[2], v0[3]); o.z = cvt_pk_bf16(v1[0], v1[1]); o.w = cvt_pk_bf16(v1[2], v1[3]);
                *(u32x4*)(ACT + (size_t)r * 256 + u.pn * 128 + wc * 32 + 8 * fq) = o; }
    }
};
struct EpiYE {
    static constexpr bool PERM = true, AFTER_DRAIN = false;
    bf16_t* YE;
    __device__ __forceinline__ void operator()(const f32x4 (&acc)[2][2][4][2], const UnitG& u, int wr, int wc, int fr, int fq) const {
        const int row0 = u.pm * BM + wr * 64 + fr;
#pragma unroll
        for (int ai = 0; ai < 2; ++ai)
#pragma unroll
            for (int m = 0; m < 4; ++m) { bf16_t* rowp = YE + (size_t)(row0 + ai * HALF + m * 16) * 1024 + u.pn * BM + wc * 32 + 8 * fq;
#pragma unroll
                for (int bj = 0; bj < 2; ++bj) { const f32x4 v0 = acc[ai][bj][m][0], v1 = acc[ai][bj][m][1];
                    u32x4 o; o.x = cvt_pk_bf16(v0[0], v0[1]); o.y = cvt_pk_bf16(v0[2], v0[3]); o.z = cvt_pk_bf16(v1[0], v1[1]); o.w = cvt_pk_bf16(v1[2], v1[3]);
                    *(u32x4*)(rowp + bj * HALF) = o; } }
    }
};
}
namespace tl {
typedef short bf16x8 __attribute__((ext_vector_type(8)));
typedef short s16x4 __attribute__((ext_vector_type(4)));
typedef float f32x4 __attribute__((ext_vector_type(4)));
typedef unsigned u32x4 __attribute__((ext_vector_type(4)));
typedef unsigned u32x2 __attribute__((ext_vector_type(2)));
constexpr int TILE_BYTES = 32768;
constexpr int STAT_OFF = 131072 + 1024;
__device__ __forceinline__ unsigned off_b(unsigned row, unsigned ch) { return 256u * row + 16u * (ch ^ (((row & 3u) << 2) | ((row >> 2) & 3u))); }
__device__ __forceinline__ unsigned cvtpk(float lo, float hi) { return pg8::cvt_pk_bf16(lo, hi); }
__device__ __forceinline__ float blo(unsigned w) { return __uint_as_float(w << 16); }
__device__ __forceinline__ float bhi(unsigned w) { return __uint_as_float(w & 0xffff0000u); }

__device__ __forceinline__ void stage_plain(LAS unsigned char* tile, const bf16* g, size_t ld, int tid) {
#pragma unroll
    for (int i = 0; i < 4; ++i) { const int idx = tid + 512 * i, row = idx >> 4, ch = idx & 15;
        const u32x4 v = *(const u32x4*)(g + (size_t)row * ld + ch * 8);
        *(LAS u32x4*)(tile + off_b(row, ch)) = v; }
}
__device__ __forceinline__ u32x4 scale8(u32x4 v, float s) {
    u32x4 o; o.x = cvtpk(blo(v.x) * s, bhi(v.x) * s); o.y = cvtpk(blo(v.y) * s, bhi(v.y) * s); o.z = cvtpk(blo(v.z) * s, bhi(v.z) * s); o.w = cvtpk(blo(v.w) * s, bhi(v.w) * s); return o;
}
__device__ __forceinline__ void stage_decay(LAS unsigned char* tile, const bf16* g, size_t ld, int tid, float l2g) {
#pragma unroll
    for (int i = 0; i < 4; ++i) { const int idx = tid + 512 * i, row = idx >> 4, ch = idx & 15;
        const u32x4 v = *(const u32x4*)(g + (size_t)row * ld + ch * 8);
        *(LAS u32x4*)(tile + off_b(row, ch)) = scale8(v, exp2f((float)(127 - row) * l2g)); }
}
__device__ __forceinline__ void stage_rmsrow(LAS unsigned char* tile, const bf16* g, size_t ld, int tid) {
#pragma unroll
    for (int i = 0; i < 4; ++i) { const int idx = tid + 512 * i, row = idx >> 4, ch = idx & 15;
        const u32x4 v = *(const u32x4*)(g + (size_t)row * ld + ch * 8);
        float ss = (blo(v.x) * blo(v.x) + bhi(v.x) * bhi(v.x)) + (blo(v.y) * blo(v.y) + bhi(v.y) * bhi(v.y)) + (blo(v.z) * blo(v.z) + bhi(v.z) * bhi(v.z)) + (blo(v.w) * blo(v.w) + bhi(v.w) * bhi(v.w));
        ss += __shfl_xor(ss, 1); ss += __shfl_xor(ss, 2); ss += __shfl_xor(ss, 4); ss += __shfl_xor(ss, 8);
        *(LAS u32x4*)(tile + off_b(row, ch)) = scale8(v, 1.0f / sqrtf(ss * (1.0f / 128.0f) + EPS)); }
}
template <int NB> __device__ __forceinline__ void ld_row(const LAS unsigned char* tile, int rowbase, int fr, int fq, bf16x8 (&f)[NB][4]) {
#pragma unroll
    for (int i = 0; i < NB; ++i)
#pragma unroll
        for (int s = 0; s < 4; ++s) f[i][s] = *(const LAS bf16x8*)(tile + off_b(rowbase + 16 * i + fr, 4 * s + fq));
}
__device__ __forceinline__ void ld_tr(const LAS unsigned char* tile, int c, int lane, bf16x8 (&f)[4]) {
    const unsigned g = lane >> 4, q = (lane & 15) >> 2, p = lane & 3;
    const unsigned base = (unsigned)(size_t)tile;
    const unsigned a0 = base + off_b(8 * g + q, 2 * c + (p >> 1)) + 8 * (p & 1);
    const unsigned a1 = base + off_b(8 * g + 4 + q, 2 * c + (p >> 1)) + 8 * (p & 1);
    s16x4 l0, h0, l1, h1, l2, h2, l3, h3;
    asm volatile("ds_read_b64_tr_b16 %0, %8\n\tds_read_b64_tr_b16 %1, %9\n\t"
                 "ds_read_b64_tr_b16 %2, %8 offset:8192\n\tds_read_b64_tr_b16 %3, %9 offset:8192\n\t"
                 "ds_read_b64_tr_b16 %4, %8 offset:16384\n\tds_read_b64_tr_b16 %5, %9 offset:16384\n\t"
                 "ds_read_b64_tr_b16 %6, %8 offset:24576\n\tds_read_b64_tr_b16 %7, %9 offset:24576\n\t"
                 "s_waitcnt lgkmcnt(0)"
                 : "=&v"(l0), "=&v"(h0), "=&v"(l1), "=&v"(h1), "=&v"(l2), "=&v"(h2), "=&v"(l3), "=&v"(h3) : "v"(a0), "v"(a1) : "memory");
    f[0] = __builtin_shufflevector(l0, h0, 0, 1, 2, 3, 4, 5, 6, 7); f[1] = __builtin_shufflevector(l1, h1, 0, 1, 2, 3, 4, 5, 6, 7);
    f[2] = __builtin_shufflevector(l2, h2, 0, 1, 2, 3, 4, 5, 6, 7); f[3] = __builtin_shufflevector(l3, h3, 0, 1, 2, 3, 4, 5, 6, 7);
}
__device__ __forceinline__ void mma(f32x4 (&acc)[4][2], const bf16x8 (&A)[4][4], const bf16x8 (&B)[2][4]) {
#pragma unroll
    for (int s = 0; s < 4; ++s)
#pragma unroll
        for (int m = 0; m < 4; ++m)
#pragma unroll
            for (int n = 0; n < 2; ++n) acc[m][n] = __builtin_amdgcn_mfma_f32_16x16x32_bf16(B[n][s], A[m][s], acc[m][n], 0, 0, 0);
}
__device__ __forceinline__ void zero(f32x4 (&acc)[4][2]) {
#pragma unroll
    for (int m = 0; m < 4; ++m)
#pragma unroll
        for (int n = 0; n < 2; ++n) acc[m][n] = (f32x4){0.f, 0.f, 0.f, 0.f};
}

#define TL_BAR() do { asm volatile("s_waitcnt lgkmcnt(0)" ::: "memory"); __builtin_amdgcn_s_barrier(); asm volatile("" ::: "memory"); } while (0)
__device__ __forceinline__ void pf_tile(u32x4 (&r)[4], const bf16* g, int tid) {
#pragma unroll
    for (int i = 0; i < 4; ++i) r[i] = *(const u32x4*)(g + (size_t)(tid + 512 * i) * 8);
}
template <int NB> __device__ __forceinline__ void ldg_row(const bf16* g, int rowbase, int fr, int fq, bf16x8 (&f)[NB][4]) {
#pragma unroll
    for (int i = 0; i < NB; ++i)
#pragma unroll
        for (int s = 0; s < 4; ++s) f[i][s] = *(const bf16x8*)(g + (size_t)(rowbase + 16 * i + fr) * 128 + 32 * s + 8 * fq);
}

__device__ __forceinline__ void phase_kv(LAS unsigned char* lds, const bf16* PROJ, bf16* KVT, int bid, int G) {
    const int tid = threadIdx.x, lane = tid & 63, wid = __builtin_amdgcn_readfirstlane(tid >> 6), wr = wid >> 2, wc = wid & 3, fr = lane & 15, fq = lane >> 4;
    int u = bid; if (u >= 512) return;
    u32x4 pk[4], pv[4];
    { const int h = u & 3; const size_t t0 = (size_t)(u >> 8) * S_ + (size_t)((u >> 2) & 63) * CH;
      pf_tile(pk, PROJ + ((size_t)(4 + h) * T_ + t0) * 128, tid); pf_tile(pv, PROJ + ((size_t)(8 + h) * T_ + t0) * 128, tid); }
    int par = 0;
    for (;;) {
        LAS unsigned char* tK = lds + par * 2 * TILE_BYTES; LAS unsigned char* tV = tK + TILE_BYTES;
        const float l2g = log2_gamma(u & 3);
#pragma unroll
        for (int i = 0; i < 4; ++i) { const int idx = tid + 512 * i, row = idx >> 4, ch = idx & 15;
            *(LAS u32x4*)(tK + off_b(row, ch)) = scale8(pk[i], exp2f((float)(127 - row) * l2g));
            *(LAS u32x4*)(tV + off_b(row, ch)) = pv[i]; }
        TL_BAR();
        const int un = u + G; const bool has_next = un < 512;
        if (has_next) { const int h = un & 3; const size_t t0 = (size_t)(un >> 8) * S_ + (size_t)((un >> 2) & 63) * CH;
            pf_tile(pk, PROJ + ((size_t)(4 + h) * T_ + t0) * 128, tid); pf_tile(pv, PROJ + ((size_t)(8 + h) * T_ + t0) * 128, tid); }
        bf16x8 A[4][4], Bf[2][4];
#pragma unroll
        for (int m = 0; m < 4; ++m) ld_tr(tV, 4 * wr + m, lane, A[m]);
#pragma unroll
        for (int nn = 0; nn < 2; ++nn) ld_tr(tK, 2 * wc + nn, lane, Bf[nn]);
        f32x4 acc[4][2]; zero(acc); mma(acc, A, Bf);
        bf16* o = KVT + (size_t)u * 16384;
#pragma unroll
        for (int m = 0; m < 4; ++m)
#pragma unroll
            for (int nn = 0; nn < 2; ++nn) { u32x2 w; w.x = cvtpk(acc[m][nn][0], acc[m][nn][1]); w.y = cvtpk(acc[m][nn][2], acc[m][nn][3]);
                *(u32x2*)(o + (64 * wr + 16 * m + fr) * 128 + 32 * wc + 16 * nn + 4 * fq) = w; }
        if (!has_next) break;
        u = un; par ^= 1;
    }
    TL_BAR();
}
__device__ __forceinline__ void phase_sgu(LAS unsigned char* lds, const bf16* PROJ, const bf16* WSM, const float* bs, const float* gain, bf16* MIX, int bid, int G) {
    const int tid = threadIdx.x, lane = tid & 63, wid = __builtin_amdgcn_readfirstlane(tid >> 6), wr = wid >> 2, wc = wid & 3, fr = lane & 15, fq = lane >> 4;
    int u = bid; if (u >= 512) return;
    u32x4 pv[4]; u32x2 uu[4][2];
    { const int g = u & 3; const size_t t0 = (size_t)(u >> 8) * S_ + (size_t)((u >> 2) & 63) * CH;
      pf_tile(pv, PROJ + ((size_t)(20 + g) * T_ + t0) * 128, tid);
#pragma unroll
      for (int m = 0; m < 4; ++m)
#pragma unroll
          for (int nn = 0; nn < 2; ++nn) uu[m][nn] = *(const u32x2*)(PROJ + ((size_t)(16 + g) * T_ + t0 + 64 * wr + 16 * m + fr) * 128 + 32 * wc + 16 * nn + 4 * fq); }
    int par = 0, gcur = -1;
    bf16x8 A[4][4]; f32x4 gn[2]; float bi[4];
    for (;;) {
        LAS unsigned char* tV = lds + par * TILE_BYTES;
        const int g = u & 3; const size_t t0 = (size_t)(u >> 8) * S_ + (size_t)((u >> 2) & 63) * CH;
        if (g != gcur) {
            gcur = g; ldg_row<4>(WSM + (size_t)g * 16384, 64 * wr, fr, fq, A);
#pragma unroll
            for (int nn = 0; nn < 2; ++nn) gn[nn] = *(const f32x4*)(gain + g * 128 + 32 * wc + 16 * nn + 4 * fq);
#pragma unroll
            for (int m = 0; m < 4; ++m) bi[m] = bs[g * 128 + 64 * wr + 16 * m + fr];
        }
#pragma unroll
        for (int i = 0; i < 4; ++i) { const int idx = tid + 512 * i, row = idx >> 4, ch = idx & 15; const u32x4 v = pv[i];
            float ss = (blo(v.x) * blo(v.x) + bhi(v.x) * bhi(v.x)) + (blo(v.y) * blo(v.y) + bhi(v.y) * bhi(v.y)) + (blo(v.z) * blo(v.z) + bhi(v.z) * bhi(v.z)) + (blo(v.w) * blo(v.w) + bhi(v.w) * bhi(v.w));
            ss += __shfl_xor(ss, 1); ss += __shfl_xor(ss, 2); ss += __shfl_xor(ss, 4); ss += __shfl_xor(ss, 8);
            *(LAS u32x4*)(tV + off_b(row, ch)) = scale8(v, 1.0f / sqrtf(ss * (1.0f / 128.0f) + EPS)); }
        TL_BAR();
        u32x2 uc[4][2];
#pragma unroll
        for (int m = 0; m < 4; ++m)
#pragma unroll
            for (int nn = 0; nn < 2; ++nn) uc[m][nn] = uu[m][nn];
        const int un = u + G; const bool has_next = un < 512;
        if (has_next) { const int g2 = un & 3; const size_t t2 = (size_t)(un >> 8) * S_ + (size_t)((un >> 2) & 63) * CH;
            pf_tile(pv, PROJ + ((size_t)(20 + g2) * T_ + t2) * 128, tid);
#pragma unroll
            for (int m = 0; m < 4; ++m)
#pragma unroll
                for (int nn = 0; nn < 2; ++nn) uu[m][nn] = *(const u32x2*)(PROJ + ((size_t)(16 + g2) * T_ + t2 + 64 * wr + 16 * m + fr) * 128 + 32 * wc + 16 * nn + 4 * fq); }
        bf16x8 Bf[2][4];
#pragma unroll
        for (int nn = 0; nn < 2; ++nn) ld_tr(tV, 2 * wc + nn, lane, Bf[nn]);
        f32x4 acc[4][2]; zero(acc); mma(acc, A, Bf);
#pragma unroll
        for (int m = 0; m < 4; ++m) { const int i = 64 * wr + 16 * m + fr;
#pragma unroll
            for (int nn = 0; nn < 2; ++nn) { const int c = 32 * wc + 16 * nn + 4 * fq;
                const f32x4 sv = acc[m][nn] * gn[nn] + bi[m];
                u32x2 o; o.x = cvtpk(blo(uc[m][nn].x) * sv[0], bhi(uc[m][nn].x) * sv[1]); o.y = cvtpk(blo(uc[m][nn].y) * sv[2], bhi(uc[m][nn].y) * sv[3]);
                *(u32x2*)(MIX + (t0 + i) * D_ + 512 + g * 128 + c) = o; } }
        if (!has_next) break;
        u = un; par ^= 1;
    }
    TL_BAR();
}
__device__ __forceinline__ void phase_ret(LAS unsigned char* lds, const bf16* PROJ, const bf16* ST, const float* gn_gain, bf16* MIX, int bid, int G) {
    const int tid = threadIdx.x, lane = tid & 63, wid = __builtin_amdgcn_readfirstlane(tid >> 6), wr = wid >> 2, wc = wid & 3, fr = lane & 15, fq = lane >> 4;
    int u = bid; if (u >= 512) return;
    u32x4 pv[4];
    { const int h = u & 3; const size_t t0 = (size_t)(u >> 8) * S_ + (size_t)((u >> 2) & 63) * CH; pf_tile(pv, PROJ + ((size_t)(8 + h) * T_ + t0) * 128, tid); }
    int par = 0;
    for (;;) {
        LAS unsigned char* tV = lds + par * 2 * TILE_BYTES; LAS unsigned char* tP = tV + TILE_BYTES;
        LAS float* stat = (LAS float*)(lds + 4 * TILE_BYTES + 1024 + par * 4096);
        const int h = u & 3; const size_t t0 = (size_t)(u >> 8) * S_ + (size_t)((u >> 2) & 63) * CH;
        const float l2g = log2_gamma(h);
        bf16x8 A[4][4], Bs[2][4], Bk[2][4];
        ldg_row<4>(PROJ + ((size_t)(0 + h) * T_ + t0) * 128, 64 * wr, fr, fq, A);
        ldg_row<2>(PROJ + ((size_t)(4 + h) * T_ + t0) * 128, 32 * wc, fr, fq, Bk);
#pragma unroll
        for (int i = 0; i < 4; ++i) { const int idx = tid + 512 * i; *(LAS u32x4*)(tV + off_b(idx >> 4, idx & 15)) = pv[i]; }
        { f32x4 accS[4][2]; zero(accS); mma(accS, A, Bk);
          asm volatile("" ::: "memory");
          ldg_row<2>(ST + (size_t)u * 16384, 32 * wc, fr, fq, Bs);
#pragma unroll
          for (int m = 0; m < 4; ++m) { const int i = 64 * wr + 16 * m + fr;
#pragma unroll
              for (int nn = 0; nn < 2; ++nn) { const int j0 = 32 * wc + 16 * nn + 4 * fq; float pvv[4];
#pragma unroll
                  for (int v = 0; v < 4; ++v) { const int dd = i - (j0 + v); pvv[v] = dd >= 0 ? accS[m][nn][v] * exp2f((float)dd * l2g) : 0.f; }
                  u32x2 o; o.x = cvtpk(pvv[0], pvv[1]); o.y = cvtpk(pvv[2], pvv[3]);
                  *(LAS u32x2*)(tP + off_b(i, 4 * wc + 2 * nn + (fq >> 1)) + 8 * (fq & 1)) = o; } } }
        f32x4 accO[4][2]; zero(accO); mma(accO, A, Bs);
#pragma unroll
        for (int m = 0; m < 4; ++m) { const float qd = exp2f((float)(64 * wr + 16 * m + fr + 1) * l2g);
#pragma unroll
            for (int nn = 0; nn < 2; ++nn) accO[m][nn] *= qd; }
        TL_BAR();
        const int un = u + G; const bool has_next = un < 512;
        if (has_next) { const int h2 = un & 3; const size_t t2 = (size_t)(un >> 8) * S_ + (size_t)((un >> 2) & 63) * CH; pf_tile(pv, PROJ + ((size_t)(8 + h2) * T_ + t2) * 128, tid); }
        ld_row<4>(tP, 64 * wr, fr, fq, A);
#pragma unroll
        for (int nn = 0; nn < 2; ++nn) ld_tr(tV, 2 * wc + nn, lane, Bs[nn]);
        mma(accO, A, Bs);
        u32x2 gt[4][2]; f32x4 gg[2];
#pragma unroll
        for (int nn = 0; nn < 2; ++nn) gg[nn] = *(const f32x4*)(gn_gain + h * 128 + 32 * wc + 16 * nn + 4 * fq);
#pragma unroll
        for (int m = 0; m < 4; ++m)
#pragma unroll
            for (int nn = 0; nn < 2; ++nn) gt[m][nn] = *(const u32x2*)(PROJ + ((size_t)(12 + h) * T_ + t0 + 64 * wr + 16 * m + fr) * 128 + 32 * wc + 16 * nn + 4 * fq);
#pragma unroll
        for (int m = 0; m < 4; ++m) { float sm = 0.f, q = 0.f;
#pragma unroll
            for (int nn = 0; nn < 2; ++nn) { const f32x4 x = accO[m][nn]; sm += (x[0] + x[1]) + (x[2] + x[3]); q += (x[0] * x[0] + x[1] * x[1]) + (x[2] * x[2] + x[3] * x[3]); }
            sm += __shfl_xor(sm, 16); sm += __shfl_xor(sm, 32); q += __shfl_xor(q, 16); q += __shfl_xor(q, 32);
            if (fq == 0) { const int i = 64 * wr + 16 * m + fr; stat[(i * 4 + wc) * 2] = sm; stat[(i * 4 + wc) * 2 + 1] = q; } }
        TL_BAR();
#pragma unroll
        for (int m = 0; m < 4; ++m) { const int i = 64 * wr + 16 * m + fr;
            const f32x4 p0 = *(const LAS f32x4*)(stat + i * 8), p1 = *(const LAS f32x4*)(stat + i * 8 + 4);
            const float mu = ((p0[0] + p0[2]) + (p1[0] + p1[2])) * (1.0f / 128.0f);
            const float var = fmaxf(((p0[1] + p0[3]) + (p1[1] + p1[3])) * (1.0f / 128.0f) - mu * mu, 0.f);
            const float rstd = 1.0f / sqrtf(var + EPS);
#pragma unroll
            for (int nn = 0; nn < 2; ++nn) { const int e = 32 * wc + 16 * nn + 4 * fq;
                const f32x4 y = (accO[m][nn] - mu) * rstd * gg[nn];
                u32x2 o; o.x = cvtpk(y[0] * blo(gt[m][nn].x), y[1] * bhi(gt[m][nn].x)); o.y = cvtpk(y[2] * blo(gt[m][nn].y), y[3] * bhi(gt[m][nn].y));
                *(u32x2*)(MIX + (t0 + i) * D_ + h * 128 + e) = o; } }
        if (!has_next) break;
        u = un; par ^= 1;
    }
    TL_BAR();
}
#undef TL_BAR
}
#define XB_TMO      128
#define XB_XCNT(j)  (256  + 64 * (j))
#define XB_XSUB(j)  (1280 + 64 * (j))
#define XB_XGEN(j)  (2304 + 64 * (j))
#define XB_TOP      3328
#define XB_TOPGEN   3392
#define XCD_BAR_WORDS 3456
#define XB_SPIN_CAP (1u << 18)

__device__ __forceinline__ unsigned xb_ld(unsigned* p)              { return __hip_atomic_load(p, __ATOMIC_RELAXED, __HIP_MEMORY_SCOPE_AGENT); }
__device__ __forceinline__ unsigned xb_add(unsigned* p, unsigned v) { return __hip_atomic_fetch_add(p, v, __ATOMIC_RELAXED, __HIP_MEMORY_SCOPE_AGENT); }
__device__ __forceinline__ unsigned xb_xcc_id() { return (unsigned)__builtin_amdgcn_s_getreg((3 << 11) | 20) & 0xFu; }
#define XB_SPIN(cond, bar) do { unsigned _sp = 0; while (cond) { __builtin_amdgcn_s_sleep(1); \
    if ((++_sp & 255u) == 0u) { if (xb_ld(&(bar)[XB_TMO])) break; if (_sp > XB_SPIN_CAP) { atomicAdd(&(bar)[XB_TMO], 1u); break; } } } } while (0)

struct XcdBarrier {
    unsigned* bar; unsigned x;
    volatile LAS unsigned* st;
};

__device__ __forceinline__ XcdBarrier xcd_barrier_post(unsigned* bar, volatile LAS unsigned* st) {
    XcdBarrier b; b.bar = bar; b.x = xb_xcc_id(); b.st = st;
    if (threadIdx.x == 0) (void)xb_add(&bar[XB_XCNT(b.x)], 1u);
    return b;
}
__device__ __forceinline__ void xcd_barrier_complete(unsigned* bar, unsigned x, unsigned& nloc, unsigned& nx) {
    const unsigned G = gridDim.x * gridDim.y * gridDim.z;
    unsigned sum, cnt, mine, sp = 0u;
    for (;;) {
        sum = 0u; cnt = 0u; mine = 0u;
#pragma unroll
        for (unsigned j = 0; j < 16; ++j) { const unsigned c = xb_ld(&bar[XB_XCNT(j)]); sum += c; cnt += (c > 0u) ? 1u : 0u; mine = (j == x) ? c : mine; }
        if (sum == G) break;
        __builtin_amdgcn_s_sleep(1);
        if ((++sp & 255u) == 0u) { if (xb_ld(&bar[XB_TMO])) break; if (sp > XB_SPIN_CAP) { atomicAdd(&bar[XB_TMO], 1u); break; } }
    }
    nloc = mine > 0u ? mine : 1u; nx = cnt > 0u ? cnt : 1u;
}

__device__ __forceinline__ void xcd_barrier(const XcdBarrier& b) {
    asm volatile("s_waitcnt vmcnt(0)" ::: "memory");
    __syncthreads();
    if (threadIdx.x == 0) {
        unsigned* bar = b.bar;
        __builtin_amdgcn_s_waitcnt(0);
        unsigned nloc = b.st[0], nx = b.st[1];
        if (nloc == 0u) { xcd_barrier_complete(bar, b.x, nloc, nx); b.st[0] = nloc; b.st[1] = nx; }
        const unsigned old = xb_add(&bar[XB_XSUB(b.x)], 1u);
        const unsigned gen = old / nloc;
        if (old + 1u == (gen + 1u) * nloc) {
            __builtin_amdgcn_fence(__ATOMIC_RELEASE, "agent");
            asm volatile("s_waitcnt vmcnt(0)" ::: "memory");
            const unsigned og = xb_add(&bar[XB_TOP], 1u);
            const unsigned tg = og / nx;
            if (og + 1u == (tg + 1u) * nx) xb_add(&bar[XB_TOPGEN], 1u);
            else XB_SPIN(xb_ld(&bar[XB_TOPGEN]) == tg, bar);
            __builtin_amdgcn_fence(__ATOMIC_ACQUIRE, "agent");
            xb_add(&bar[XB_XGEN(b.x)], 1u);
            asm volatile("s_waitcnt vmcnt(0)" ::: "memory");
        } else {
            XB_SPIN(xb_ld(&bar[XB_XGEN(b.x)]) == gen, bar);
            __builtin_amdgcn_fence(__ATOMIC_ACQUIRE, "agent");
            asm volatile("s_waitcnt vmcnt(0)" ::: "memory");
        }
    }
    __syncthreads();
}
constexpr int NWAVES = 8;
constexpr int RING_OFF = 0, RING_BYTES = 131072;
constexpr int LDSCTL_OFF = RING_BYTES, MISC_OFF = LDSCTL_OFF + 320;
constexpr int LDS_BYTES = 163840;
constexpr int SLOT_OFF = RING_BYTES + 8192;
constexpr int CW_BAR = 4096;
constexpr size_t CTL_ZERO_BYTES = 64 * 1024;
static_assert((CW_BAR + XCD_BAR_WORDS) * 4 <= (int)CTL_ZERO_BYTES, "ctl");
#define LDS_WAIT() asm volatile("s_waitcnt lgkmcnt(0)" ::: "memory")

struct Args { P p; int ph_lo, ph_hi; };

template <class RowMap>
__device__ __forceinline__ void tr_item(const float* W, int K, int N, bf16* WT, LAS float* scr, int item, int lane, RowMap rm, const float* kscale = nullptr) {
    const int nblk = N / 32, kb = item / nblk, nb = item % nblk, k0 = 64 * kb, n0 = 32 * nb;
    float wv[32];
#pragma unroll
    for (int i = 0; i < 32; ++i) { const int kk = 2 * i + (lane >> 5); wv[i] = W[(size_t)(k0 + kk) * N + n0 + (lane & 31)]; }
#pragma unroll
    for (int i = 0; i < 32; ++i) { const int kk = 2 * i + (lane >> 5); scr[kk * 33 + (lane & 31)] = wv[i]; }
    LDS_WAIT(); asm volatile("" ::: "memory");
    const int c = lane & 7;
    f32x4 g0 = (f32x4){1.f, 1.f, 1.f, 1.f}, g1 = g0;
    if (kscale) { g0 = *(const f32x4*)(kscale + k0 + 8 * c); g1 = *(const f32x4*)(kscale + k0 + 8 * c + 4); }
#pragma unroll
    for (int j = 0; j < 4; ++j) { const int n = (lane >> 3) + 8 * j; const LAS float* s = scr + (8 * c) * 33 + n;
        pg8::u32x4 o; o.x = pk2(s[0 * 33] * g0[0], s[1 * 33] * g0[1]); o.y = pk2(s[2 * 33] * g0[2], s[3 * 33] * g0[3]); o.z = pk2(s[4 * 33] * g1[0], s[5 * 33] * g1[1]); o.w = pk2(s[6 * 33] * g1[2], s[7 * 33] * g1[3]);
        *(pg8::u32x4*)(WT + (size_t)rm(n0 + n) * K + k0 + 8 * c) = o; }
    LDS_WAIT(); asm volatile("" ::: "memory");
}
struct RmId { __device__ __forceinline__ int operator()(int n) const { return n; } };
struct RmQK { __device__ __forceinline__ int operator()(int a) const { return a >= 1024 ? a : ((a & ~127) | (((a >> 4) & 3) << 5) | (((a >> 2) & 3) << 3) | (((a >> 6) & 1) << 2) | (a & 3)); } };
struct RmGU { int add; __device__ __forceinline__ int operator()(int f) const { return 256 * (f >> 7) + add + (f & 127); } };

__device__ __forceinline__ void ph_prologue(const P& p, LAS unsigned char* lds, int bid, int nblk) {
    const int tid = threadIdx.x, lane = tid & 63, wave = __builtin_amdgcn_readfirstlane(tid >> 6);
    const int gw = bid * NWAVES + wave, ngw = nblk * NWAVES, gt = bid * (NWAVES * 64) + tid, ngt = nblk * NWAVES * 64;
    unsigned char* ws = p.ws;
    LAS float* scr = (LAS float*)(lds + wave * 16384);
    bf16* WIN_T = (bf16*)(ws + WS_WIN_T); bf16* WOUT_T = (bf16*)(ws + WS_WOUT_T); bf16* WGU_T = (bf16*)(ws + WS_WGU_T); bf16* WDN_T = (bf16*)(ws + WS_WDN_T);
    constexpr int I_IN = 16 * 96, I_OUT = 16 * 32, I_E = 128, NITEMS = I_IN + I_OUT + NEXP * 3 * I_E;
    for (int it = gw; it < NITEMS; it += ngw) {
        int r = it;
        if (r < I_IN) { tr_item(p.w_in, D_, NIN, WIN_T, scr, r, lane, RmQK{}); continue; } r -= I_IN;
        if (r < I_OUT) { tr_item(p.w_out, D_, D_, WOUT_T, scr, r, lane, RmId{}); continue; } r -= I_OUT;
        const int e = r / (3 * I_E), q = r % (3 * I_E);
        if (q < I_E) tr_item(p.w_gu + (size_t)e * D_ * FF, D_, FF, WGU_T + (size_t)e * 512 * D_, scr, q, lane, RmGU{0}, p.g_ffn);
        else if (q < 2 * I_E) tr_item(p.w_up + (size_t)e * D_ * FF, D_, FF, WGU_T + (size_t)e * 512 * D_, scr, q - I_E, lane, RmGU{128}, p.g_ffn);
        else tr_item(p.w_dn + (size_t)e * FF * D_, FF, D_, WDN_T + (size_t)e * D_ * FF, scr, q - 2 * I_E, lane, RmId{});
    }
    ph_rmsnorm_bf16(p.x, p.g_mix, (bf16*)(ws + WS_H), gw, ngw, lane);
    { float* COS = (float*)(ws + WS_ROPE); float* SIN = COS + (size_t)T_ * 64;
      for (int i = gt; i < T_ * 64; i += ngt) { const int t = i >> 6, j = i & 63; float sn, cs; sincosf((float)p.pos[t] * inv_freq(j), &sn, &cs); COS[i] = cs; SIN[i] = sn; } }
    { bf16* WSM = (bf16*)(ws + WS_WSM);
      for (int i = gt; i < 4 * 128 * 128; i += ngt) { const int jj = i & 127, ii = (i >> 7) & 127; WSM[i] = jj <= ii ? f2bf(p.sgu_w[i]) : (bf16)0; }
      bf16* WRT = (bf16*)(ws + WS_WRT);
      for (int i = gt; i < 48 * 1024; i += ngt) { const int o = i >> 10, k = i & 1023;
          const float w = (o < 32 ? p.w_re[((size_t)(o >> 3) * D_ + k) * 8 + (o & 7)] : (o < 36 ? p.w_rg[k * 4 + (o - 32)] : 0.f)) * p.g_ffn[k];
          const bf16 hi = f2bf(w); WRT[i] = hi; WRT[48 * 1024 + i] = f2bf(w - bf2f(hi)); } }
}

__global__ void __launch_bounds__(NWAVES * 64, 2) mk_fwd(Args args) {
    extern __shared__ __attribute__((aligned(16))) unsigned char lds_raw[];
    LAS unsigned char* lds = (LAS unsigned char*)lds_raw;
    volatile LAS unsigned* MISC = (volatile LAS unsigned*)(lds + MISC_OFF);
    const P& p = args.p;
    const int tid = threadIdx.x, lane = tid & 63, wave = __builtin_amdgcn_readfirstlane(tid >> 6);
    const int G = gridDim.x, bid = blockIdx.x;
    const int gw = bid * NWAVES + wave, ngw = G * NWAVES, gt = bid * (NWAVES * 64) + tid, ngt = G * NWAVES * 64;
    unsigned char* ws = p.ws;
    for (int u = tid; u < (LDS_BYTES - LDSCTL_OFF) / 4; u += NWAVES * 64) ((LAS unsigned*)(lds + LDSCTL_OFF))[u] = 0u;
    __syncthreads();
    const int lo = args.ph_lo, hi = args.ph_hi;
    XcdBarrier bar; bar.bar = (unsigned*)(ws + WS_CTL) + CW_BAR; bar.x = 0; bar.st = nullptr;
    if (hi - lo > 1) bar = xcd_barrier_post((unsigned*)(ws + WS_CTL) + CW_BAR, MISC + 8);
#ifndef DUP_PHASE
#define DUP_PHASE -1
#endif
#define IN(k) (lo <= (k) && (k) < hi)
#define PH(k) for (int rep_ = 0; rep_ < ((DUP_PHASE == (k)) ? 2 : 1); ++rep_)
#define SEAM(k) do { if (IN(k) && IN((k) + 1)) xcd_barrier(bar); } while (0)

    bf16* H = (bf16*)(ws + WS_H); bf16* PROJ = (bf16*)(ws + WS_PROJ); bf16* KVT = (bf16*)(ws + WS_KVT); bf16* ST = (bf16*)(ws + WS_ST); bf16* MIX = (bf16*)(ws + WS_MIX);
    float* SSQ = (float*)(ws + WS_SSQ); int4* ROUTE = (int4*)(ws + WS_ROUTE); int* CNT = (int*)(ws + WS_CNT); int* ETOK = (int*)(ws + WS_ETOK); float* EW = (float*)(ws + WS_EW);
    int2* TOKPOS = (int2*)(ws + WS_TOKPOS); int* TILE = (int*)(ws + WS_TILE); bf16* YE = (bf16*)(ws + WS_YE);
    bf16* X1B = (bf16*)(ws + WS_X1B); float* RSTD = (float*)(ws + WS_RSTD); float* ERS = (float*)(ws + WS_ERS);

    if (IN(0)) PH(0) { ph_prologue(p, lds, bid, G); SEAM(0); }
    if (IN(1)) PH(1) {
        pg8::Gemm g{H, (const bf16*)(ws + WS_WIN_T), T_, NIN, D_}; pg8::StaticOrder S; S.init(T_, NIN, G, bid);
        pg8::EpiProj E{PROJ, (const float*)(ws + WS_ROPE), (const float*)(ws + WS_ROPE) + (size_t)T_ * 64};
        pg8::gemm_phase<pg8::EpiProj, pg8::StaticOrder, true, true>(lds + RING_OFF, g, S, E);
        SEAM(1);
    }
    if (IN(2)) PH(2) {
        tl::phase_kv(lds, PROJ, KVT, bid, G);
        tl::phase_sgu(lds, PROJ, (const bf16*)(ws + WS_WSM), p.sgu_b, p.sgu_gain, MIX, bid, G);
        SEAM(2);
    }
    if (IN(3)) PH(3) { ph_scan(KVT, ST, gt, ngt); SEAM(3); }
    if (IN(4)) PH(4) { tl::phase_ret(lds, PROJ, ST, p.gn_gain, MIX, bid, G); SEAM(4); }
    if (IN(5)) PH(5) {
        pg8::Gemm g{MIX, (const bf16*)(ws + WS_WOUT_T), T_, D_, D_}; pg8::StaticOrder S; S.init(T_, D_, G, bid);
        pg8::EpiRes2 E{p.x, X1B, SSQ, (const bf16*)(ws + WS_WRT), (float*)(ws + WS_LP), (LAS float*)(lds + SLOT_OFF)};
        pg8::gemm_phase<pg8::EpiRes2, pg8::StaticOrder, true, true>(lds + RING_OFF, g, S, E);
        SEAM(5);
    }
    if (IN(6)) PH(6) { ph_route((const float*)(ws + WS_LP), SSQ, p.b_rg, p.b_re, ROUTE, RSTD, CNT, gw, ngw, lane); SEAM(6); }
    if (IN(7)) PH(7) { __syncthreads(); ph_lists(ROUTE, CNT, RSTD, ETOK, EW, ERS, TOKPOS, TILE, (int*)lds_raw, bid, G); SEAM(7); }
    if (IN(8)) PH(8) {
        pg8::MoeASched S{TILE, ETOK, (const char*)X1B, (const char*)(ws + WS_WGU_T), G, bid}; pg8::EpiAct E{(bf16*)(ws + WS_ACT), EW, ERS};
        pg8::gemm_phase_g<pg8::EpiAct, pg8::MoeASched>(lds + RING_OFF, D_, S, E);
        SEAM(8);
    }
    if (IN(9)) PH(9) {
        pg8::MoeBSched S{TILE, (const char*)(ws + WS_ACT), (const char*)(ws + WS_WDN_T), G, bid}; pg8::EpiYE E{YE};
        pg8::gemm_phase_g<pg8::EpiYE, pg8::MoeBSched>(lds + RING_OFF, FF, S, E);
        SEAM(9);
    }
    if (IN(10)) { ph_final(p.out, X1B, YE, TOKPOS, p.g_fin, gw, ngw, lane); }
#undef IN
#undef PH
#undef SEAM
}

extern "C" void kernel_launch(void* const* d_in, const int* in_sizes, int n_in, void* d_out, int out_size, void* d_ws, size_t ws_size, hipStream_t stream) {
    static int grid = 0;
    if (grid == 0) {
        if (n_in != 18 || ws_size < WS_END) fprintf(stderr, "kernel_launch: unexpected n_in %d / ws_size %zu\n", n_in, ws_size);
        (void)hipFuncSetAttribute((const void*)mk_fwd, hipFuncAttributeMaxDynamicSharedMemorySize, LDS_BYTES);
        int dev = 0, cus = 0, per_cu = 0;
        (void)hipGetDevice(&dev); (void)hipDeviceGetAttribute(&cus, hipDeviceAttributeMultiprocessorCount, dev);
        (void)hipOccupancyMaxActiveBlocksPerMultiprocessor(&per_cu, (const void*)mk_fwd, NWAVES * 64, LDS_BYTES);
        if (per_cu < 1) fprintf(stderr, "kernel_launch: occupancy query says %d blocks per CU\n", per_cu);
        (void)hipGetLastError();
        grid = cus > 0 ? cus : 256;
    }
    P p{};
    p.x = (const float*)d_in[0]; p.pos = (const int*)d_in[1]; p.g_mix = (const float*)d_in[2]; p.w_in = (const float*)d_in[3]; p.gn_gain = (const float*)d_in[4];
    p.sgu_gain = (const float*)d_in[5]; p.sgu_w = (const float*)d_in[6]; p.sgu_b = (const float*)d_in[7]; p.w_out = (const float*)d_in[8]; p.g_ffn = (const float*)d_in[9];
    p.w_rg = (const float*)d_in[10]; p.b_rg = (const float*)d_in[11]; p.w_re = (const float*)d_in[12]; p.b_re = (const float*)d_in[13];
    p.w_gu = (const float*)d_in[14]; p.w_up = (const float*)d_in[15]; p.w_dn = (const float*)d_in[16]; p.g_fin = (const float*)d_in[17];
    p.out = (float*)d_out; p.ws = (unsigned char*)d_ws;
    unsigned char* ws = p.ws;
    bf16* PROJ = (bf16*)(ws + WS_PROJ); bf16* KVT = (bf16*)(ws + WS_KVT); bf16* ST = (bf16*)(ws + WS_ST); bf16* MIX = (bf16*)(ws + WS_MIX);
    float* SSQ = (float*)(ws + WS_SSQ); int4* ROUTE = (int4*)(ws + WS_ROUTE); int* CNT = (int*)(ws + WS_CNT); int* ETOK = (int*)(ws + WS_ETOK); float* EW = (float*)(ws + WS_EW);
    int* TILE = (int*)(ws + WS_TILE); float* TMP = (float*)(ws + WS_TMP); bf16* ACT = (bf16*)(ws + WS_ACT); bf16* YE = (bf16*)(ws + WS_YE);
    bf16* H2 = (bf16*)(ws + WS_H);
    (void)ST; (void)SSQ;
    (void)hipMemsetAsync(ws + WS_CTL, 0, CTL_ZERO_BYTES, stream);
#define MK(lo, hi) do { Args a{}; a.p = p; a.ph_lo = (lo); a.ph_hi = (hi); hipLaunchKernelGGL(mk_fwd, dim3(grid), dim3(NWAVES * 64), LDS_BYTES, stream, a); } while (0)
#ifdef DUPL
    MK(0, DUPL + 1); MK(DUPL, DUPL + 1); for (int k_ = DUPL + 1; k_ < 11; ++k_) MK(k_, k_ + 1);
#else
    MK(0, 11);
#endif
    (void)PROJ; (void)KVT; (void)MIX; (void)H2; (void)ROUTE; (void)CNT; (void)TMP; (void)ACT; (void)YE; (void)ETOK; (void)EW; (void)TILE;
#undef MK
}
```
